# Optimizing an MI355X kernel written in HIP

```python
import math, functools
import jax, jax.numpy as jnp
from jax import lax
import numpy as np

D_MODEL = 4096
BATCH = 8
SEQ = 2048
DEPTH = 1
DEC_BATCH = 32
DEC_SEQ = 32
PAST_LEN = 2048

CHUNK = 64
GMLP_CHUNK = 128
D_A = D_MODEL // 2
G_A = 8
HEAD_DIM = 128
N_HEADS = D_MODEL // 256
N_KV_HEADS = N_HEADS // 4
ROT_DIM = HEAD_DIM // 4
N_IDX_HEADS = 16
IDX_DIM = 64
IDX_ROT = IDX_DIM // 4
TOPK_MAX = 256
QBLOCK = 64
ROPE_THETA = 500000.0
D_FF = 256 * ((8 * D_MODEL // 3 + 255) // 256)
CONV_WIDTH = 3
EPS = 1e-6
IN_SIZES = (D_A, D_A, N_HEADS * HEAD_DIM, N_KV_HEADS * HEAD_DIM, N_KV_HEADS * HEAD_DIM,
            N_IDX_HEADS * IDX_DIM, IDX_DIM, N_IDX_HEADS, D_MODEL, D_MODEL)
IN_COLS = sum(IN_SIZES)

kernel_name = "hybrid_gmlp_dsa_convffn_stream_step"


def rms_norm(x, g):
    xf = x.astype(jnp.float32)
    y = xf * lax.rsqrt(jnp.mean(xf * xf, axis=-1, keepdims=True) + EPS)
    return (y * g.astype(jnp.float32)).astype(x.dtype)


def partial_rope(x, pos, rot_dim):
    half = rot_dim // 2
    inv_freq = ROPE_THETA ** (-jnp.arange(half, dtype=jnp.float32) / half)
    ang = pos.astype(jnp.float32)[:, None] * inv_freq[None, :]
    cos = jnp.cos(ang)[None, :, None, :]
    sin = jnp.sin(ang)[None, :, None, :]
    xf = x.astype(jnp.float32)
    x1 = xf[..., :half]
    x2 = xf[..., half:rot_dim]
    out = jnp.concatenate([x1 * cos - x2 * sin, x2 * cos + x1 * sin, xf[..., rot_dim:]], axis=-1)
    return out.astype(x.dtype)


def project(h, w_in, pos):
    B, T, _ = h.shape
    offs = [int(o) for o in np.cumsum(IN_SIZES)[:-1]]
    u_a, v_a, q, k, v, q_idx, k_idx, w_idx, g_a, g_b = jnp.split(h @ w_in, offs, axis=-1)
    q = partial_rope(q.reshape(B, T, N_HEADS, HEAD_DIM), pos, ROT_DIM)
    k = partial_rope(k.reshape(B, T, N_KV_HEADS, HEAD_DIM), pos, ROT_DIM)
    v = v.reshape(B, T, N_KV_HEADS, HEAD_DIM)
    q_idx = partial_rope(q_idx.reshape(B, T, N_IDX_HEADS, IDX_DIM), pos, IDX_ROT)
    k_idx = partial_rope(k_idx[:, :, None, :], pos, IDX_ROT)[:, :, 0]
    w_idx = w_idx * (N_IDX_HEADS ** -0.5 * IDX_DIM ** -0.5)
    return u_a, v_a, q, k, v, q_idx, k_idx, w_idx, g_a, g_b


def gmlp_spatial(u, v, g_norm, ws, b):
    B, T, _ = v.shape
    vn = rms_norm(v, g_norm)
    n_c = -(-T // GMLP_CHUNK)
    tp = n_c * GMLP_CHUNK
    vp = jnp.pad(vn, ((0, 0), (0, tp - T), (0, 0))).reshape(B, n_c, GMLP_CHUNK, G_A, D_A // G_A)
    i = jnp.arange(GMLP_CHUNK)
    mask = (i[None, :] // CHUNK) <= (i[:, None] // CHUNK)
    wm = jnp.where(mask[None], ws, 0)
    s = jnp.einsum('gij,bcjgd->bcigd', wm, vp) + jnp.transpose(b)[None, None, :, :, None]
    s = s.reshape(B, tp, D_A)[:, :T]
    return u * s, vn


def dsa_attend(q, q_idx, w_idx, qpos, k_all, v_all, kidx_all, kpos, topk):
    B, Tq = q.shape[:2]
    admissible = (kpos[None, :] // CHUNK) <= (qpos[:, None] // CHUNK)
    rel = jax.nn.relu(jnp.einsum('bthd,bsd->bths', q_idx, kidx_all).astype(jnp.float32))
    score = jnp.einsum('bths,bth->bts', rel, w_idx.astype(jnp.float32))
    score = jnp.where(admissible[None], score, -jnp.inf)
    _, idx = lax.top_k(score, topk)
    k_sel = jax.vmap(lambda kk, ii: kk[ii])(k_all, idx)
    v_sel = jax.vmap(lambda vv, ii: vv[ii])(v_all, idx)
    valid = (kpos[idx] // CHUNK) <= (qpos[None, :, None] // CHUNK)
    qg = q.reshape(B, Tq, N_KV_HEADS, N_HEADS // N_KV_HEADS, HEAD_DIM)
    logits = jnp.einsum('btngd,btsnd->btngs', qg, k_sel).astype(jnp.float32) * (HEAD_DIM ** -0.5)
    logits = jnp.where(valid[:, :, None, None, :], logits, -jnp.inf)
    p = jax.nn.softmax(logits, axis=-1).astype(v_sel.dtype)
    out = jnp.einsum('btngs,btsnd->btngd', p, v_sel)
    return out.reshape(B, Tq, N_HEADS * HEAD_DIM)


def dsa_prompt(q, q_idx, w_idx, pos, k, v, k_idx, topk):
    B, S = q.shape[:2]
    nb = S // QBLOCK

    def blk(a):
        return jnp.swapaxes(a.reshape((B, nb, QBLOCK) + a.shape[2:]), 0, 1)

    def one(args):
        qb, qib, wib, posb = args
        return dsa_attend(qb, qib, wib, posb, k, v, k_idx, pos, topk)

    out = lax.map(one, (blk(q), blk(q_idx), blk(w_idx), pos.reshape(nb, QBLOCK)))
    return jnp.swapaxes(out, 0, 1).reshape(B, S, N_HEADS * HEAD_DIM)


def merge_branches(a_out, b_out, g_a, g_b, w_a, w_b, w_o):
    y = jax.nn.sigmoid(g_a) * (a_out @ w_a) + jax.nn.sigmoid(g_b) * (b_out @ w_b)
    return y @ w_o


def conv_ffn(h, buf, w_up, conv_w, conv_b, w_down):
    T = h.shape[1]
    z = h @ w_up
    zp = jnp.concatenate([buf.astype(z.dtype), z], axis=1)
    c = conv_b
    for tap in range(CONV_WIDTH):
        c = c + conv_w[tap] * zp[:, tap:tap + T]
    gate, up = jnp.split(c, 2, axis=-1)
    return (jax.nn.silu(gate) * up) @ w_down, zp[:, -(CONV_WIDTH - 1):]


def setup_inputs(seed: int = 0) -> dict:
    key = jax.random.key(seed)
    ks = jax.random.split(key, 24)
    f32 = jnp.float32

    def nrm(k, shape, scale=1.0):
        return jax.random.normal(k, shape, f32) * scale

    return {
        "x_prompt": nrm(ks[0], (BATCH, SEQ, D_MODEL)),
        "x_sample": nrm(ks[1], (DEC_BATCH, DEC_SEQ, D_MODEL)),
        "cache_k": nrm(ks[2], (DEPTH, DEC_BATCH, PAST_LEN, N_KV_HEADS, HEAD_DIM)),
        "cache_v": nrm(ks[3], (DEPTH, DEC_BATCH, PAST_LEN, N_KV_HEADS, HEAD_DIM)),
        "cache_kidx": nrm(ks[4], (DEPTH, DEC_BATCH, PAST_LEN, IDX_DIM)),
        "state_ffn_conv": nrm(ks[5], (DEPTH, DEC_BATCH, CONV_WIDTH - 1, 2 * D_FF)),
        "norm_attn_g": 1.0 + nrm(ks[6], (DEPTH, D_MODEL), 0.02),
        "w_in": nrm(ks[7], (DEPTH, D_MODEL, IN_COLS), D_MODEL ** -0.5),
        "gmlp_norm_g": 1.0 + nrm(ks[8], (DEPTH, D_A), 0.02),
        "gmlp_ws": nrm(ks[9], (DEPTH, G_A, GMLP_CHUNK, GMLP_CHUNK), GMLP_CHUNK ** -0.5),
        "gmlp_b": nrm(ks[10], (DEPTH, G_A, GMLP_CHUNK), 0.02),
        "w_branch_a": nrm(ks[11], (DEPTH, D_A, D_MODEL), D_A ** -0.5),
        "w_branch_b": nrm(ks[12], (DEPTH, N_HEADS * HEAD_DIM, D_MODEL), (N_HEADS * HEAD_DIM) ** -0.5),
        "w_out": nrm(ks[13], (DEPTH, D_MODEL, D_MODEL), D_MODEL ** -0.5),
        "norm_ffn_g": 1.0 + nrm(ks[14], (DEPTH, D_MODEL), 0.02),
        "w_up": nrm(ks[15], (DEPTH, D_MODEL, 2 * D_FF), D_MODEL ** -0.5),
        "conv_w": nrm(ks[16], (DEPTH, CONV_WIDTH, 2 * D_FF), CONV_WIDTH ** -0.5),
        "conv_b": nrm(ks[17], (DEPTH, 2 * D_FF), 0.02),
        "w_down": nrm(ks[18], (DEPTH, D_FF, D_MODEL), D_FF ** -0.5),
        "norm_final_g": 1.0 + nrm(ks[19], (D_MODEL,), 0.02),
    }


def reference(x_prompt, x_sample, cache_k, cache_v, cache_kidx, state_ffn_conv,
              norm_attn_g, w_in, gmlp_norm_g, gmlp_ws, gmlp_b, w_branch_a, w_branch_b,
              w_out, norm_ffn_g, w_up, conv_w, conv_b, w_down, norm_final_g):
    B, S, _ = x_prompt.shape
    DB, T, _ = x_sample.shape
    P = cache_k.shape[2]
    pos_p = jnp.arange(S, dtype=jnp.int32)
    pos_s = P + jnp.arange(T, dtype=jnp.int32)
    kpos_s = jnp.arange(P + T, dtype=jnp.int32)
    topk_p = min(TOPK_MAX, S // 4)
    topk_s = min(TOPK_MAX, (P + T) // 4)

    xp, xs = x_prompt, x_sample
    kp_l, vp_l, kip_l, cp_l = [], [], [], []
    ks_l, vs_l, kis_l, cs_l, gv_l = [], [], [], [], []
    for l in range(DEPTH):
        hp = rms_norm(xp, norm_attn_g[l])
        u_a, v_a, q, k, v, qi, ki, wi, ga, gb = project(hp, w_in[l], pos_p)
        a_out, _ = gmlp_spatial(u_a, v_a, gmlp_norm_g[l], gmlp_ws[l], gmlp_b[l])
        b_out = dsa_prompt(q, qi, wi, pos_p, k, v, ki, topk_p)
        xp = xp + merge_branches(a_out, b_out, ga, gb, w_branch_a[l], w_branch_b[l], w_out[l])
        buf0 = jnp.zeros((B, CONV_WIDTH - 1, 2 * D_FF), dtype=xp.dtype)
        f_out, cbuf_p = conv_ffn(rms_norm(xp, norm_ffn_g[l]), buf0, w_up[l], conv_w[l], conv_b[l], w_down[l])
        xp = xp + f_out
        kp_l.append(k); vp_l.append(v); kip_l.append(ki); cp_l.append(cbuf_p)

        hs = rms_norm(xs, norm_attn_g[l])
        u_a, v_a, q, k, v, qi, ki, wi, ga, gb = project(hs, w_in[l], pos_s)
        a_out, vn = gmlp_spatial(u_a, v_a, gmlp_norm_g[l], gmlp_ws[l], gmlp_b[l])
        k_all = jnp.concatenate([cache_k[l].astype(k.dtype), k], axis=1)
        v_all = jnp.concatenate([cache_v[l].astype(v.dtype), v], axis=1)
        ki_all = jnp.concatenate([cache_kidx[l].astype(ki.dtype), ki], axis=1)
        b_out = dsa_attend(q, qi, wi, pos_s, k_all, v_all, ki_all, kpos_s, topk_s)
        xs = xs + merge_branches(a_out, b_out, ga, gb, w_branch_a[l], w_branch_b[l], w_out[l])
        f_out, cbuf_s = conv_ffn(rms_norm(xs, norm_ffn_g[l]), state_ffn_conv[l], w_up[l], conv_w[l], conv_b[l], w_down[l])
        xs = xs + f_out
        ks_l.append(k); vs_l.append(v); kis_l.append(ki); cs_l.append(cbuf_s); gv_l.append(vn)

    y_prompt = rms_norm(xp, norm_final_g)
    y_sample = rms_norm(xs, norm_final_g)
    new_cache_k_prompt = jnp.stack(kp_l)
    new_cache_v_prompt = jnp.stack(vp_l)
    new_cache_kidx_prompt = jnp.stack(kip_l)
    new_state_ffn_conv_prompt = jnp.stack(cp_l)
    new_cache_k_sample = jnp.stack(ks_l)
    new_cache_v_sample = jnp.stack(vs_l)
    new_cache_kidx_sample = jnp.stack(kis_l)
    new_state_ffn_conv_sample = jnp.stack(cs_l)
    new_state_gmlp_v_sample = jnp.stack(gv_l)
    return (y_prompt, y_sample, new_cache_k_prompt, new_cache_v_prompt, new_cache_kidx_prompt,
            new_state_ffn_conv_prompt, new_cache_k_sample, new_cache_v_sample, new_cache_kidx_sample,
            new_state_ffn_conv_sample, new_state_gmlp_v_sample)
```

```cpp
#include <hip/hip_runtime.h>
#include <cstdio>
#include <cstdint>
namespace pg8 {
#define PG8_LAS __attribute__((address_space(3)))
typedef unsigned short bf16_t;
typedef short bf16x8 __attribute__((ext_vector_type(8)));
typedef float f32x4 __attribute__((ext_vector_type(4)));
typedef unsigned u32x4 __attribute__((ext_vector_type(4)));
constexpr int BM = 256, BK = 64, HALF = 128, HTB = HALF * BK * 2  , STAGE_BYTES = 8 * HTB, NXCD = 8, WGM = 8;

__host__ __device__ __forceinline__ int lds_byte(int r, int c) { const int st = (r >> 4) * 2 + (c >> 5), rr = r & 15, cc = c & 31, ob = rr * 64 + cc * 2; return st * 1024 + (ob ^ (((ob >> 9) & 1) << 5)); }
__host__ __device__ __forceinline__ void stage_rc(int b, int& R, int& C) { const int st = b / 1024, sb = b % 1024, swz = sb ^ (((sb >> 9) & 1) << 5); R = (st >> 1) * 16 + swz / 64; C = (st & 1) * 32 + (swz % 64) / 2; }
__host__ __device__ __forceinline__ int perm32(int rho) { const int n = rho >> 4, i = rho & 15; return 8 * (i >> 2) + 4 * n + (i & 3); }

struct Unit { int pm, pn; };
struct Gemm { const bf16_t* A; const bf16_t* Bt; int M, N, K, ld; };

struct StaticOrder {
    int nM, nN, nwg, G, c;
    __host__ __device__ void init(int M, int N, int G_, int c_) { nM = M / BM; nN = N / BM; nwg = nM * nN; G = G_; c = c_; }
    __host__ __device__ bool next(int i, Unit& u) const {
        const long L = (long)i * G + c; if (L >= nwg) return false;
        int wgid = (int)L; { const int q = nwg / NXCD, r = nwg % NXCD, xcd = wgid % NXCD, off = wgid / NXCD; wgid = (xcd < r ? xcd * (q + 1) : r * (q + 1) + (xcd - r) * q) + off; }
        const int nig = WGM * nN, gid = wgid / nig, fm = gid * WGM, gsz = (nM - fm) < WGM ? (nM - fm) : WGM;
        u.pm = fm + ((wgid % nig) % gsz); u.pn = (wgid % nig) / gsz; return true;
    }
    __device__ __forceinline__ void a_ready(const Unit&) const {}
    __device__ __forceinline__ void done(const Unit&) const {}
};
__device__ __forceinline__ unsigned cvt_pk_bf16(float lo, float hi) { unsigned r; asm volatile("v_cvt_pk_bf16_f32 %0, %1, %2" : "=v"(r) : "v"(lo), "v"(hi)); return r; }
template <class Epi, class Sched, bool ALIGN_EPI = false, bool SP2 = false>
__device__ __forceinline__ void gemm_phase(PG8_LAS unsigned char* lds, const Gemm g, const Sched& S, const Epi& E) {
    int tid_ = threadIdx.x; asm volatile("" : "+v"(tid_));
    const int tid = tid_, wid = __builtin_amdgcn_readfirstlane(tid >> 6), lane = tid & 63, wr = wid >> 2, wc = wid & 3, fr = lane & 15, fq = lane >> 4;
    const int K = g.K, nt = K / BK;
    unsigned voffA[2], voffB[2];
#pragma unroll
    for (int i = 0; i < 2; ++i) { int R, C; stage_rc(tid * 16 + i * 8192, R, C); const int Rb = Epi::PERM ? ((R & ~31) + perm32(R & 31)) : R;
        voffA[i] = (unsigned)(R * g.ld + C) * 2u; voffB[i] = (unsigned)(Rb * g.ld + C) * 2u; }
    const size_t kstep = (size_t)(BK * 2);
    const size_t hstep = (size_t)HALF * g.ld * 2;
    const size_t tstep = 2 * hstep;
    const unsigned ldsw = (unsigned)wid * 1024u;
    const int aoff = lds_byte(wr * 64 + fr, fq * 8), boff = lds_byte(wc * 32 + fr, fq * 8);
#define PG8_SA(b, h) (((b) * 2 + (h)) * HTB)
#define PG8_SB(b, h) ((4 + (b) * 2 + (h)) * HTB)
#define PG8_STAGE(bufoff, gbase, voff) do { _Pragma("unroll") for (int _i = 0; _i < 2; ++_i) \
        __builtin_amdgcn_global_load_lds((const unsigned*)((const char*)(gbase) + (voff)[_i]), (PG8_LAS unsigned*)(lds + (bufoff) + ldsw + _i * 8192), 16, 0, 0); } while (0)
#define PG8_LDA(dst, b, h) do { _Pragma("unroll") for (int m = 0; m < 4; ++m) _Pragma("unroll") for (int k = 0; k < 2; ++k) dst[m][k] = *(const PG8_LAS bf16x8*)(lds + PG8_SA(b, h) + aoff + m * 2048 + k * 1024); } while (0)
#define PG8_LDB(dst, b, h) do { _Pragma("unroll") for (int n = 0; n < 2; ++n) _Pragma("unroll") for (int k = 0; k < 2; ++k) dst[n][k] = *(const PG8_LAS bf16x8*)(lds + PG8_SB(b, h) + boff + n * 2048 + k * 1024); } while (0)
#define PG8_MMA(ai, bj, At, Bt) do { __builtin_amdgcn_s_setprio(1); _Pragma("unroll") for (int m = 0; m < 4; ++m) _Pragma("unroll") for (int n = 0; n < 2; ++n) _Pragma("unroll") for (int k = 0; k < 2; ++k) \
        acc[ai][bj][m][n] = __builtin_amdgcn_mfma_f32_16x16x32_bf16(Bt[n][k], At[m][k], acc[ai][bj][m][n], 0, 0, 0); __builtin_amdgcn_s_setprio(0); } while (0)
#define PG8_WAIT_V(n) asm volatile("s_waitcnt vmcnt(" #n ")" ::: "memory")
#define PG8_WAIT_L(n) asm volatile("s_waitcnt lgkmcnt(" #n ")" ::: "memory")
#define PG8_BAR __builtin_amdgcn_s_barrier()
#define PG8_SCHED __builtin_amdgcn_sched_barrier(0)
    Unit cur, nxt; int ui = 0;
    if (!S.next(0, cur)) return;
    f32x4 acc[2][2][4][2];
#pragma unroll
    for (int a = 0; a < 2; ++a)
#pragma unroll
        for (int b = 0; b < 2; ++b)
#pragma unroll
            for (int m = 0; m < 4; ++m)
#pragma unroll
                for (int n = 0; n < 2; ++n) acc[a][b][m][n] = (f32x4){0.f, 0.f, 0.f, 0.f};
    bf16x8 At[4][2], B0[2][2], B1[2][2];
    const char* cA = (const char*)g.A + (size_t)cur.pm * tstep; const char* cB = (const char*)g.Bt + (size_t)cur.pn * tstep;
    S.a_ready(cur);
    if constexpr (SP2) {
        PG8_STAGE(PG8_SB(0, 0), cB, voffB); PG8_STAGE(PG8_SB(0, 1), cB + hstep, voffB); PG8_STAGE(PG8_SA(0, 0), cA, voffA); PG8_STAGE(PG8_SA(0, 1), cA + hstep, voffA);
        if (wr == 1) PG8_BAR;
        PG8_WAIT_V(2); PG8_BAR;
        PG8_STAGE(PG8_SB(1, 0), cB + kstep, voffB); PG8_STAGE(PG8_SA(1, 0), cA + kstep, voffA); PG8_STAGE(PG8_SB(1, 1), cB + hstep + kstep, voffB);
        PG8_WAIT_V(6); PG8_BAR;
    } else {
        PG8_STAGE(PG8_SB(0, 0), cB, voffB); PG8_STAGE(PG8_SA(0, 0), cA, voffA); PG8_STAGE(PG8_SB(0, 1), cB + hstep, voffB); PG8_STAGE(PG8_SA(0, 1), cA + hstep, voffA);
        if (wr == 1) PG8_BAR;
        PG8_WAIT_V(4); PG8_BAR;
        PG8_STAGE(PG8_SB(1, 0), cB + kstep, voffB); PG8_STAGE(PG8_SA(1, 0), cA + kstep, voffA); PG8_STAGE(PG8_SB(1, 1), cB + hstep + kstep, voffB);
        PG8_WAIT_V(6); PG8_BAR;
    }
    for (;;) {
        const bool has_next = S.next(ui + 1, nxt);
        const char* nA = has_next ? (const char*)g.A + (size_t)nxt.pm * tstep : cA; const char* nB = has_next ? (const char*)g.Bt + (size_t)nxt.pn * tstep : cB;
        for (int t = 0; t < nt; t += 2) {
            const bool last = (t == nt - 2);
            const char* a1 = cA + (size_t)(t + 1) * kstep;
            const char* a2 = last ? nA : cA + (size_t)(t + 2) * kstep; const char* b2 = last ? nB : cB + (size_t)(t + 2) * kstep;
            const char* a3 = a2 + kstep; const char* b3 = b2 + kstep;
            if (last && has_next) S.a_ready(nxt);
            if constexpr (SP2) {
            PG8_LDB(B0, 0, 0); PG8_LDB(B1, 0, 1); PG8_SCHED; PG8_LDA(At, 0, 0); PG8_STAGE(PG8_SA(1, 1), a1 + hstep, voffA);
            PG8_WAIT_V(8); PG8_WAIT_L(0); PG8_BAR; PG8_MMA(0, 0, At, B0); PG8_MMA(0, 1, At, B1); PG8_BAR; PG8_SCHED;
            PG8_LDA(At, 0, 1); PG8_STAGE(PG8_SB(0, 0), b2, voffB); PG8_STAGE(PG8_SB(0, 1), b2 + hstep, voffB); PG8_STAGE(PG8_SA(0, 0), a2, voffA);
            PG8_WAIT_V(8); PG8_WAIT_L(0); PG8_BAR; PG8_MMA(1, 0, At, B0); PG8_MMA(1, 1, At, B1); PG8_BAR; PG8_SCHED;
            PG8_LDB(B0, 1, 0); PG8_LDB(B1, 1, 1); PG8_SCHED; PG8_LDA(At, 1, 0); PG8_STAGE(PG8_SA(0, 1), a2 + hstep, voffA);
            PG8_WAIT_V(8); PG8_WAIT_L(0); PG8_BAR; PG8_MMA(0, 0, At, B0); PG8_MMA(0, 1, At, B1); PG8_BAR; PG8_SCHED;
            PG8_LDA(At, 1, 1); PG8_STAGE(PG8_SB(1, 0), b3, voffB); PG8_STAGE(PG8_SB(1, 1), b3 + hstep, voffB); PG8_STAGE(PG8_SA(1, 0), a3, voffA);
            PG8_WAIT_V(8); PG8_WAIT_L(0); PG8_BAR; PG8_MMA(1, 0, At, B0); PG8_MMA(1, 1, At, B1); PG8_BAR; PG8_SCHED;
            } else {
            PG8_LDB(B0, 0, 0); PG8_SCHED; PG8_LDA(At, 0, 0); PG8_STAGE(PG8_SA(1, 1), a1 + hstep, voffA);
            PG8_WAIT_L(8); PG8_BAR; PG8_WAIT_L(0); PG8_MMA(0, 0, At, B0); PG8_BAR; PG8_SCHED;
            PG8_LDB(B1, 0, 1); PG8_STAGE(PG8_SB(0, 0), b2, voffB);
            PG8_BAR; PG8_WAIT_L(0); PG8_MMA(0, 1, At, B1); PG8_BAR;
            PG8_LDA(At, 0, 1); PG8_STAGE(PG8_SA(0, 0), a2, voffA);
            PG8_BAR; PG8_WAIT_L(0); PG8_MMA(1, 0, At, B0); PG8_BAR; PG8_SCHED;
            PG8_STAGE(PG8_SB(0, 1), b2 + hstep, voffB);
            PG8_WAIT_V(6); PG8_BAR; PG8_MMA(1, 1, At, B1); PG8_BAR;
            PG8_LDB(B0, 1, 0); PG8_SCHED; PG8_LDA(At, 1, 0); PG8_STAGE(PG8_SA(0, 1), a2 + hstep, voffA);
            PG8_WAIT_L(8); PG8_BAR; PG8_WAIT_L(0); PG8_MMA(0, 0, At, B0); PG8_BAR; PG8_SCHED;
            PG8_LDB(B1, 1, 1); PG8_STAGE(PG8_SB(1, 0), b3, voffB);
            PG8_BAR; PG8_WAIT_L(0); PG8_MMA(0, 1, At, B1); PG8_BAR;
            PG8_LDA(At, 1, 1); PG8_STAGE(PG8_SA(1, 0), a3, voffA);
            PG8_BAR; PG8_WAIT_L(0); PG8_MMA(1, 0, At, B0); PG8_BAR; PG8_SCHED;
            PG8_STAGE(PG8_SB(1, 1), b3 + hstep, voffB);
            PG8_WAIT_V(6); PG8_BAR; PG8_MMA(1, 1, At, B1); PG8_BAR;
            }
        }
        if constexpr (ALIGN_EPI) { if (wr == 0) PG8_BAR; }
        if constexpr (!Epi::AFTER_DRAIN) { E(acc, cur, wr, wc, fr, fq); S.done(cur); }
        if (!has_next) break;
#pragma unroll
        for (int a = 0; a < 2; ++a)
#pragma unroll
            for (int b = 0; b < 2; ++b)
#pragma unroll
                for (int m = 0; m < 4; ++m)
#pragma unroll
                    for (int n = 0; n < 2; ++n) acc[a][b][m][n] = (f32x4){0.f, 0.f, 0.f, 0.f};
        cur = nxt; cA = nA; cB = nB; ++ui;
        if constexpr (ALIGN_EPI) { if (wr == 1) PG8_BAR; }
    }
    PG8_WAIT_V(0);
    if constexpr (!ALIGN_EPI) { if (wr == 0) PG8_BAR; }
    PG8_BAR;
    if constexpr (Epi::AFTER_DRAIN) { E.fused(acc, cur, wr, wc, fr, fq, lds, wid, lane); S.done(cur); }
#undef PG8_SA
#undef PG8_SB
#undef PG8_STAGE
#undef PG8_LDA
#undef PG8_LDB
#undef PG8_MMA
#undef PG8_WAIT_V
#undef PG8_WAIT_L
#undef PG8_BAR
#undef PG8_SCHED
}
}

constexpr int NWAVES = 8, NTHREADS = 512;
constexpr int DM = 4096;
constexpr int MP = 16384, MS = 1024, MT = MP + MS;
constexpr int DA = 2048, QW = 2048, KVW = 512, IDXW = 1024, IDXD = 64;
constexpr int DFF = 11008, NUP = 22016;
constexpr int INCOLS = 16464, N1 = 16640;
constexpr int LCAT = 2176;
constexpr int MTILES = 34;
constexpr int SCW = 2112;
constexpr float EPS = 1e-6f;
constexpr size_t O_YP = 0, O_YS = 67108864, O_KP = 71303168, O_VP = 79691776, O_KIP = 88080384, O_CP = 89128960,
                 O_KS = 89481216, O_VS = 90005504, O_KIS = 90529792, O_CS = 90595328, O_GV = 92004352, O_END = 94101504;
constexpr size_t MiB = 1u << 20;
constexpr size_t WS_CTL = 0, CTL_ZERO_BYTES = 1 * MiB;
constexpr size_t WS_TABQ = 1 * MiB, WS_TABI = WS_TABQ + 2080 * 16 * 8, WS_WSB = WS_TABI + 2080 * 8 * 8;
static_assert(WS_WSB + 8 * 128 * 128 * 2 <= 2 * MiB, "tables");
constexpr size_t WS_MASK = 2 * MiB;
static_assert(WS_MASK + (size_t)MT * MTILES * 8 <= 8 * MiB, "mask");
constexpr size_t WS_W1T = 8 * MiB, WS_WAT = 138 * MiB, WS_WBT = 154 * MiB, WS_WOT = 170 * MiB, WS_WUPT = 202 * MiB, WS_WDNT = 374 * MiB;
constexpr size_t WS_H = 460 * MiB;
constexpr size_t WS_U = 596 * MiB, WS_V = 664 * MiB;
constexpr size_t WS_Q = 732 * MiB, WS_SA = 800 * MiB, WS_SB = 936 * MiB, WS_QI = 1072 * MiB;
constexpr size_t WS_X1B = WS_U;
constexpr size_t WS_X2B = WS_H;
constexpr size_t WS_ACT = WS_Q;
constexpr size_t WS_KP = 1106 * MiB, WS_VP = 1122 * MiB, WS_KIP = 1138 * MiB;
constexpr size_t WS_KCAT = 1140 * MiB, WS_VCAT = 1208 * MiB, WS_KICAT = 1276 * MiB;
constexpr size_t WS_PART = WS_KCAT;
static_assert((size_t)4 * MS * DM * 4 <= (size_t)32 * LCAT * KVW * 2, "partials fit in the KCAT region");
constexpr size_t WS_WI = 1285 * MiB;
constexpr size_t WS_END = 1287 * MiB;
static_assert(WS_W1T + (size_t)N1 * DM * 2 == WS_WAT && WS_WUPT + (size_t)NUP * DM * 2 == WS_WDNT && WS_WDNT + (size_t)DM * DFF * 2 == WS_H, "weights");
static_assert(WS_H + (size_t)MT * DM * 2 == WS_U && WS_U + (size_t)MT * DA * 2 == WS_V && WS_V + (size_t)MT * DA * 2 == WS_Q, "acts");
static_assert(WS_ACT + (size_t)MT * DFF * 2 <= WS_KP && WS_QI + (size_t)MT * IDXW * 2 == WS_KP, "act overlay");
static_assert(WS_KCAT + (size_t)32 * LCAT * KVW * 2 == WS_VCAT && WS_KICAT + (size_t)32 * LCAT * IDXD * 2 <= WS_WI && WS_WI + (size_t)MT * 16 * 4 <= WS_END, "caches");
static_assert((size_t)256 * 64 * SCW * 4 <= (size_t)MT * DM * 2, "scores scratch fits in the H region");
static_assert((size_t)128 * 2 * 2 * NUP * 4 <= (size_t)MT * DM * 2, "conv edge rows fit in the H region");
constexpr int CW_TMO = 0, CW_Q2 = 64, CW_Q3 = 128, CW_Q2B = 192, CW_DQ = 256, CW_DQ2 = 320, CW_DQ3 = 384, CW_DQ4 = 448, CW_DQ5 = 512, CW_BAR = 4096, CW_CL = 8192  , CW_SSQ = 65536, CW_SSQ2 = 65536 + 32768;
constexpr int RING_BYTES = 131072, LDS_BYTES = 147456,     LDSCTL_OFF = LDS_BYTES - 512, MISC_OFF = LDSCTL_OFF + 320;

#define GAS __attribute__((address_space(1)))
#define LAS __attribute__((address_space(3)))
typedef unsigned short bf16;
typedef unsigned v4u __attribute__((ext_vector_type(4)));
typedef unsigned v2u __attribute__((ext_vector_type(2)));
typedef float f32x4 __attribute__((ext_vector_type(4)));
typedef float f32x16 __attribute__((ext_vector_type(16)));
typedef short bf16x8 __attribute__((ext_vector_type(8)));
typedef short s16x4 __attribute__((ext_vector_type(4)));
typedef GAS unsigned gu32;
#define RLX_AGENT __ATOMIC_RELAXED, __HIP_MEMORY_SCOPE_AGENT
#define LDS_WAIT() asm volatile("s_waitcnt lgkmcnt(0)" ::: "memory")
#define VM_WAIT() asm volatile("s_waitcnt vmcnt(0)" ::: "memory")
using pg8::cvt_pk_bf16;
__device__ __forceinline__ float bf_lo(unsigned w) { return __uint_as_float(w << 16); }
__device__ __forceinline__ float bf_hi(unsigned w) { return __uint_as_float(w & 0xffff0000u); }
__device__ __forceinline__ bf16 f2bf1(float f) { return (bf16)(cvt_pk_bf16(f, 0.f) & 0xffffu); }
__device__ __forceinline__ v4u pack8(f32x4 a, f32x4 b) { v4u w; w.x = cvt_pk_bf16(a[0], a[1]); w.y = cvt_pk_bf16(a[2], a[3]); w.z = cvt_pk_bf16(b[0], b[1]); w.w = cvt_pk_bf16(b[2], b[3]); return w; }
__device__ __forceinline__ float sigmoidf_(float x) { return __builtin_amdgcn_rcpf(1.f + __expf(-x)); }
__device__ __forceinline__ float wave_sum(float v) {
#pragma unroll
    for (int o = 1; o < 64; o <<= 1) v += __shfl_xor(v, o);
    return v;
}
#define XB_TMO      128
#define XB_XCNT(j)  (256  + 64 * (j))
#define XB_XSUB(j)  (1280 + 64 * (j))
#define XB_XGEN(j)  (2304 + 64 * (j))
#define XB_TOP      3328
#define XB_TOPGEN   3392
#define XCD_BAR_WORDS 3456
#define XB_SPIN_CAP (1u << 18)

__device__ __forceinline__ unsigned xb_ld(unsigned* p)              { return __hip_atomic_load(p, __ATOMIC_RELAXED, __HIP_MEMORY_SCOPE_AGENT); }
__device__ __forceinline__ unsigned xb_add(unsigned* p, unsigned v) { return __hip_atomic_fetch_add(p, v, __ATOMIC_RELAXED, __HIP_MEMORY_SCOPE_AGENT); }
__device__ __forceinline__ unsigned xb_xcc_id() { return (unsigned)__builtin_amdgcn_s_getreg((3 << 11) | 20) & 0xFu; }
#define XB_SPIN(cond, bar) do { unsigned _sp = 0; while (cond) { __builtin_amdgcn_s_sleep(1); \
    if ((++_sp & 255u) == 0u) { if (xb_ld(&(bar)[XB_TMO])) break; if (_sp > XB_SPIN_CAP) { atomicAdd(&(bar)[XB_TMO], 1u); break; } } } } while (0)

struct XcdBarrier {
    unsigned* bar; unsigned x;
    volatile LAS unsigned* st;
};

__device__ __forceinline__ XcdBarrier xcd_barrier_post(unsigned* bar, volatile LAS unsigned* st) {
    XcdBarrier b; b.bar = bar; b.x = xb_xcc_id(); b.st = st;
    if (threadIdx.x == 0) (void)xb_add(&bar[XB_XCNT(b.x)], 1u);
    return b;
}
__device__ __forceinline__ void xcd_barrier_complete(unsigned* bar, unsigned x, unsigned& nloc, unsigned& nx) {
    const unsigned G = gridDim.x * gridDim.y * gridDim.z;
    unsigned sum, cnt, mine, sp = 0u;
    for (;;) {
        sum = 0u; cnt = 0u; mine = 0u;
#pragma unroll
        for (unsigned j = 0; j < 16; ++j) { const unsigned c = xb_ld(&bar[XB_XCNT(j)]); sum += c; cnt += (c > 0u) ? 1u : 0u; mine = (j == x) ? c : mine; }
        if (sum == G) break;
        __builtin_amdgcn_s_sleep(1);
        if ((++sp & 255u) == 0u) { if (xb_ld(&bar[XB_TMO])) break; if (sp > XB_SPIN_CAP) { atomicAdd(&bar[XB_TMO], 1u); break; } }
    }
    nloc = mine > 0u ? mine : 1u; nx = cnt > 0u ? cnt : 1u;
}

__device__ __forceinline__ void xcd_barrier(const XcdBarrier& b) {
    asm volatile("s_waitcnt vmcnt(0)" ::: "memory");
    __syncthreads();
    if (threadIdx.x == 0) {
        unsigned* bar = b.bar;
        __builtin_amdgcn_s_waitcnt(0);
        unsigned nloc = b.st[0], nx = b.st[1];
        if (nloc == 0u) { xcd_barrier_complete(bar, b.x, nloc, nx); b.st[0] = nloc; b.st[1] = nx; }
        const unsigned old = xb_add(&bar[XB_XSUB(b.x)], 1u);
        const unsigned gen = old / nloc;
        if (old + 1u == (gen + 1u) * nloc) {
            __builtin_amdgcn_fence(__ATOMIC_RELEASE, "agent");
            asm volatile("s_waitcnt vmcnt(0)" ::: "memory");
            const unsigned og = xb_add(&bar[XB_TOP], 1u);
            const unsigned tg = og / nx;
            if (og + 1u == (tg + 1u) * nx) xb_add(&bar[XB_TOPGEN], 1u);
            else XB_SPIN(xb_ld(&bar[XB_TOPGEN]) == tg, bar);
            __builtin_amdgcn_fence(__ATOMIC_ACQUIRE, "agent");
            xb_add(&bar[XB_XGEN(b.x)], 1u);
            asm volatile("s_waitcnt vmcnt(0)" ::: "memory");
        } else {
            XB_SPIN(xb_ld(&bar[XB_XGEN(b.x)]) == gen, bar);
            __builtin_amdgcn_fence(__ATOMIC_ACQUIRE, "agent");
            asm volatile("s_waitcnt vmcnt(0)" ::: "memory");
        }
    }
    __syncthreads();
}

struct Args { const float* in[20]; float* out; unsigned char* ws; };
typedef const __attribute__((address_space(4))) Args KA;
struct Frame {
    LAS unsigned char* lds;
    volatile LAS unsigned* MISC;
    gu32* ctl;
    int tid, lane, wave, vcu, G, qpar;
    KA* ka;
    float* out;
    unsigned char* ws;
};
__device__ __forceinline__ const float* in_ptr(KA* ka, int i) { asm volatile("" : "+s"(ka)); return ka->in[i]; }
#define INP(i) in_ptr(F.ka, (i))
#define WSP(T, off) ((T*)(F.ws + (off)))

__device__ __forceinline__ int q_next(Frame& F, int cw) {
    F.qpar ^= 1;
    volatile LAS unsigned* slot = F.MISC + F.qpar;
    if (F.tid == 0) slot[0] = __hip_atomic_fetch_add(F.ctl + cw, 1u, RLX_AGENT);
    __syncthreads();
    return (int)slot[0];
}

struct RowId   { __device__ __forceinline__ int operator()(int n) const { return n; } };
struct RowW1   { __device__ __forceinline__ int operator()(int n) const { return n < 8272 ? n : n + 176; } };
struct RowWup  { __device__ __forceinline__ int operator()(int n) const { const int u = n >= DFF, c = u ? n - DFF : n; return 256 * (c >> 7) + 128 * u + (c & 127); } };
__device__ __forceinline__ void tr_load(const float* W, int N, int kb, int nb, int lane, float (&t)[32]) {
    const int k0 = 64 * kb, nn = min(32 * nb + (lane & 31), N - 1);
    const GAS float* rp = (const GAS float*)W + (size_t)k0 * N;
    const unsigned lo = (unsigned)((lane >> 5) * N + nn);
#pragma unroll
    for (int i = 0; i < 32; ++i) t[i] = __builtin_nontemporal_load(rp + (size_t)(2 * i) * N + lo);
    __builtin_amdgcn_sched_barrier(0);
}
template <class RM>
__device__ __forceinline__ void tr_store(const float (&t)[32], int K, int N, bf16* WT, RM rm, LAS float* scr, int kb, int nb, int lane, const float* kscale) {
    const int k0 = 64 * kb, n0 = 32 * nb;
#pragma unroll
    for (int i = 0; i < 32; ++i) { const int kk = 2 * i + (lane >> 5); scr[kk * 33 + (lane & 31)] = t[i]; }
    LDS_WAIT(); asm volatile("" ::: "memory");
    const int c = lane & 7;
    f32x4 g0 = {1.f, 1.f, 1.f, 1.f}, g1 = g0;
    if (kscale) { g0 = *(const f32x4*)(kscale + k0 + 8 * c); g1 = *(const f32x4*)(kscale + k0 + 8 * c + 4); }
#pragma unroll
    for (int j = 0; j < 4; ++j) { const int n = (lane >> 3) + 8 * j; const LAS float* s = scr + (8 * c) * 33 + n;
        v4u o; o.x = cvt_pk_bf16(s[0 * 33] * g0[0], s[1 * 33] * g0[1]); o.y = cvt_pk_bf16(s[2 * 33] * g0[2], s[3 * 33] * g0[3]); o.z = cvt_pk_bf16(s[4 * 33] * g1[0], s[5 * 33] * g1[1]); o.w = cvt_pk_bf16(s[6 * 33] * g1[2], s[7 * 33] * g1[3]);
        if (n0 + n < N) *(GAS v4u*)(WT + (size_t)rm(n0 + n) * K + k0 + 8 * c) = o; }
    LDS_WAIT(); asm volatile("" ::: "memory");
}
template <class RM>
__device__ __forceinline__ void transpose_range(Frame& F, const float* W, int K, int N, bf16* WT, RM rm, const float* kscale, int it, int NGW, int nit);
template <class RM>
__device__ __forceinline__ void transpose_matrix(Frame& F, const float* W, int K, int N, bf16* WT, RM rm, const float* kscale = nullptr, int wg = -1, int nwg = 0, int kb0 = 0, int kb1 = -1) {
    const int gw = (wg < 0 ? F.vcu : wg) * NWAVES + F.wave, NGW = (wg < 0 ? F.G : nwg) * NWAVES;
    const int nnb = (N + 31) / 32, nit = (kb1 < 0 ? K / 64 : kb1) * nnb;
    transpose_range(F, W, K, N, WT, rm, kscale, kb0 * nnb + gw, NGW, nit);
}
template <class RM>
__device__ __forceinline__ void transpose_range(Frame& F, const float* W, int K, int N, bf16* WT, RM rm, const float* kscale, int it, int NGW, int nit) {
    LAS float* scr = (LAS float*)(F.lds + F.wave * 16384);
    const int nnb = (N + 31) / 32;
    if (it >= nit) return;
    const int n = (nit - it + NGW - 1) / NGW, last = it + (n - 1) * NGW;
    float t[32], u[32];
    tr_load(W, N, it / nnb, it % nnb, F.lane, t);
    for (int p = n >> 1; p > 0; --p) {
        const int i1 = it + NGW, i2 = min(i1 + NGW, last);
        tr_load(W, N, i1 / nnb, i1 % nnb, F.lane, u);
        tr_store(t, K, N, WT, rm, scr, it / nnb, it % nnb, F.lane, kscale);
        tr_load(W, N, i2 / nnb, i2 % nnb, F.lane, t);
        tr_store(u, K, N, WT, rm, scr, i1 / nnb, i1 % nnb, F.lane, kscale);
        it = i1 + NGW;
    }
    if (n & 1) tr_store(t, K, N, WT, rm, scr, last / nnb, last % nnb, F.lane, kscale);
}
__device__ __forceinline__ void rms_vals_to_bf16(const f32x4 (&v)[16], const float* g, bf16* orow, int lane) {
    float s = 0.f;
#pragma unroll
    for (int j = 0; j < 16; ++j) s += (v[j].x * v[j].x + v[j].y * v[j].y) + (v[j].z * v[j].z + v[j].w * v[j].w);
    const float r = 1.f / sqrtf(wave_sum(s) * (1.f / DM) + EPS);
    const GAS f32x4* gr = (const GAS f32x4*)g + lane;
    GAS v2u* o8 = (GAS v2u*)orow + lane;
#pragma unroll
    for (int j = 0; j < 16; ++j) { const f32x4 gg = gr[64 * j]; v2u w; w.x = cvt_pk_bf16(v[j].x * r * gg.x, v[j].y * r * gg.y); w.y = cvt_pk_bf16(v[j].z * r * gg.z, v[j].w * r * gg.w); o8[64 * j] = w; }
}
__device__ __forceinline__ void rms_row_to_bf16(const float* xrow, const float* g, bf16* orow, int lane) {
    const GAS f32x4* xr = (const GAS f32x4*)xrow + lane;
    f32x4 v[16]; float s = 0.f;
#pragma unroll
    for (int j = 0; j < 16; ++j) { v[j] = __builtin_nontemporal_load(&xr[64 * j]); s += (v[j].x * v[j].x + v[j].y * v[j].y) + (v[j].z * v[j].z + v[j].w * v[j].w); }
    const float r = 1.f / sqrtf(wave_sum(s) * (1.f / DM) + EPS);
    const GAS f32x4* gr = (const GAS f32x4*)g + lane;
    GAS v2u* o8 = (GAS v2u*)orow + lane;
#pragma unroll
    for (int j = 0; j < 16; ++j) { const f32x4 gg = gr[64 * j]; v2u w; w.x = cvt_pk_bf16(v[j].x * r * gg.x, v[j].y * r * gg.y); w.y = cvt_pk_bf16(v[j].z * r * gg.z, v[j].w * r * gg.w); o8[64 * j] = w; }
}
__device__ __forceinline__ void sincos_d(double x, double& s, double& c) {
    const double kf = __builtin_rint(x * 0.63661977236758134308);
    double r = __builtin_fma(-kf, 1.57079632679489655800e+00, x); r = __builtin_fma(-kf, 6.12323399573676603587e-17, r);
    const double r2 = r * r;
    double sp = -1.0 / 1307674368000.0; sp = sp * r2 + 1.0 / 6227020800.0; sp = sp * r2 - 1.0 / 39916800.0; sp = sp * r2 + 1.0 / 362880.0; sp = sp * r2 - 1.0 / 5040.0; sp = sp * r2 + 1.0 / 120.0; sp = sp * r2 - 1.0 / 6.0; sp = sp * r2 + 1.0;
    const double sn = r * sp;
    double cp = 1.0 / 20922789888000.0; cp = cp * r2 - 1.0 / 87178291200.0; cp = cp * r2 + 1.0 / 479001600.0; cp = cp * r2 - 1.0 / 3628800.0; cp = cp * r2 + 1.0 / 40320.0; cp = cp * r2 - 1.0 / 720.0; cp = cp * r2 + 1.0 / 24.0; cp = cp * r2 - 0.5; cp = cp * r2 + 1.0;
    const int k = ((int)kf) & 3;
    s = (k == 0) ? sn : (k == 1) ? cp : (k == 2) ? -sn : -cp;
    c = (k == 0) ? cp : (k == 1) ? -sn : (k == 2) ? -cp : sn;
}
__device__ __forceinline__ float inv_freq16(int j) {
    const float t[16] = {1.000000000e+00f, 4.403665960e-01f, 1.939227432e-01f, 8.539710194e-02f, 3.760603070e-02f, 1.656043902e-02f, 7.292664610e-03f, 3.211445874e-03f,
                         1.414213562e-03f, 6.227723788e-04f, 2.742481884e-04f, 1.207697351e-04f, 5.318296098e-05f, 2.341999971e-05f, 1.031338616e-05f, 4.541670478e-06f};
    float r = t[0];
#pragma unroll
    for (int i = 1; i < 16; ++i) r = (j == i) ? t[i] : r;
    return r;
}
__device__ __forceinline__ void p0_prologue(Frame& F) {
    const int gt = F.vcu * NTHREADS + F.tid, NGT = F.G * NTHREADS;
    const int gw = F.vcu * NWAVES + F.wave, NGW = F.G * NWAVES;
    transpose_matrix(F, INP(7), DM, INCOLS, WSP(bf16, WS_W1T), RowW1());
    { GAS v4u* z = (GAS v4u*)(F.ws + WS_W1T + (size_t)8272 * DM * 2); const int n16 = 176 * DM * 2 / 16;
      for (int i = gt; i < n16; i += NGT) z[i] = (v4u){0u, 0u, 0u, 0u}; }
    {
      const int sw = F.wave * F.G + F.vcu, np = gw < MP ? (MP - gw + NGW - 1) / NGW : 0, ns = sw < MS ? (MS - sw + NGW - 1) / NGW : 0;
      for (int i = 0; i < np + ns; ++i) { const int m = i < np ? gw + i * NGW : MP + sw + (i - np) * NGW;
        const float* xr = m < MP ? INP(0) + (size_t)m * DM : INP(1) + (size_t)(m - MP) * DM;
        rms_row_to_bf16(xr, INP(6), WSP(bf16, WS_H) + (size_t)m * DM, F.lane); } }
    {
      const int per_bi = 2048 * IDXD / 8;
      for (int i = gt; i < 32 * per_bi; i += NGT) { const int b = i / per_bi, r = i - b * per_bi;
          const GAS f32x4* si = (const GAS f32x4*)(INP(4)) + (size_t)i * 2;
          ((GAS v4u*)(F.ws + WS_KICAT))[((size_t)b * LCAT * IDXD) / 8 + r] = pack8(si[0], si[1]); }
      const int padk = 96 * KVW / 8, padi = 96 * IDXD / 8;
      for (int i = gt; i < 32 * padk; i += NGT) { const int b = i / padk, r = i - b * padk; const size_t d = ((size_t)(b * LCAT + 2080) * KVW) / 8 + r;
          ((GAS v4u*)(F.ws + WS_KCAT))[d] = (v4u){0u, 0u, 0u, 0u}; ((GAS v4u*)(F.ws + WS_VCAT))[d] = (v4u){0u, 0u, 0u, 0u}; }
      for (int i = gt; i < 32 * padi; i += NGT) { const int b = i / padi, r = i - b * padi;
          ((GAS v4u*)(F.ws + WS_KICAT))[((size_t)(b * LCAT + 2080) * IDXD) / 8 + r] = (v4u){0u, 0u, 0u, 0u}; } }
    for (int i = gt; i < 2080 * 24; i += NGT) {
        const int pos = i / 24, j = i - pos * 24;
        const float f = j < 16 ? inv_freq16(j) : inv_freq16(2 * (j - 16));
        const float ang = (float)pos * f; double s, c; sincos_d((double)ang, s, c);
        float* dst = j < 16 ? WSP(float, WS_TABQ) + (pos * 16 + j) * 2 : WSP(float, WS_TABI) + (pos * 8 + (j - 16)) * 2;
        dst[0] = (float)c; dst[1] = (float)s;
    }
    for (int i = gt; i < 8 * 128 * 128; i += NGT) { const int qi = (i >> 7) & 127, kj = i & 127; const float w = INP(9)[i];
        WSP(bf16, WS_WSB)[i] = f2bf1(((kj >> 6) <= (qi >> 6)) ? w : 0.f); }
}

using pg8::Unit;

struct EpiProj {
    static constexpr bool PERM = true, AFTER_DRAIN = false;
    unsigned char* ws; float* out;
    __device__ __forceinline__ void operator()(const f32x4 (&acc)[2][2][4][2], const Unit& u, int wr, int wc, int fr, int fq) const {
        const int pn = u.pn, pm = u.pm;
        bf16* const U = (bf16*)(ws + WS_U); bf16* const V = (bf16*)(ws + WS_V); bf16* const Q = (bf16*)(ws + WS_Q); bf16* const QI = (bf16*)(ws + WS_QI); bf16* const SA = (bf16*)(ws + WS_SA); bf16* const SB = (bf16*)(ws + WS_SB);
        bf16* const KP = (bf16*)(ws + WS_KP); bf16* const VP = (bf16*)(ws + WS_VP); bf16* const KIP = (bf16*)(ws + WS_KIP); bf16* const KCAT = (bf16*)(ws + WS_KCAT); bf16* const VCAT = (bf16*)(ws + WS_VCAT); bf16* const KICAT = (bf16*)(ws + WS_KICAT);
        float* const WI = (float*)(ws + WS_WI); float* const ssq = (float*)(ws + WS_CTL) + CW_SSQ; const float* const tabQ = (const float*)(ws + WS_TABQ); const float* const tabI = (const float*)(ws + WS_TABI);
        const int row0 = pm * 256 + wr * 64 + fr, c0 = wc * 32 + 8 * fq;
        const bool samp = pm >= 64;
        if (pn < 8 || (pn >= 33)) {
            bf16* base; int ld, cb; bool sg;
            if (pn < 8) { base = U; ld = DA; cb = pn * 256; sg = false; }
            else if (pn < 49) { base = SA; ld = DM; cb = (pn - 33) * 256; sg = true; }
            else { base = SB; ld = DM; cb = (pn - 49) * 256; sg = true; }
#pragma unroll
            for (int ai = 0; ai < 2; ++ai)
#pragma unroll
                for (int m = 0; m < 4; ++m) { bf16* rowp = base + (size_t)(row0 + ai * 128 + m * 16) * ld + cb + c0;
#pragma unroll
                    for (int bj = 0; bj < 2; ++bj) { f32x4 v0 = acc[ai][bj][m][0], v1 = acc[ai][bj][m][1];
                        if (sg) {
#pragma unroll
                            for (int i = 0; i < 4; ++i) { v0[i] = sigmoidf_(v0[i]); v1[i] = sigmoidf_(v1[i]); } }
                        *(v4u*)(rowp + bj * 128) = pack8(v0, v1); } }
        } else if (pn < 16) {
            const int cb = (pn - 8) * 256;
#pragma unroll
            for (int ai = 0; ai < 2; ++ai)
#pragma unroll
                for (int m = 0; m < 4; ++m) { const int row = row0 + ai * 128 + m * 16; bf16* rowp = V + (size_t)row * DA + cb + c0; float s = 0.f;
#pragma unroll
                    for (int bj = 0; bj < 2; ++bj) { const f32x4 v0 = acc[ai][bj][m][0], v1 = acc[ai][bj][m][1];
                        s += (v0[0] * v0[0] + v0[1] * v0[1]) + (v0[2] * v0[2] + v0[3] * v0[3]) + (v1[0] * v1[0] + v1[1] * v1[1]) + (v1[2] * v1[2] + v1[3] * v1[3]);
                        *(v4u*)(rowp + bj * 128) = pack8(v0, v1); }
                    s += __shfl_xor(s, 16); s += __shfl_xor(s, 32);
                    if (fq == 0) __hip_atomic_fetch_add(ssq + row, s, RLX_AGENT); }
        } else if (pn < 28) {
            const bool rope = pn < 26, isq = pn < 24, isk = (pn == 24 || pn == 25);
#pragma unroll
            for (int ai = 0; ai < 2; ++ai)
#pragma unroll
                for (int m = 0; m < 4; ++m) { const int row = row0 + ai * 128 + m * 16; const int pos = samp ? 2048 + (row & 31) : (row & 2047);
                    f32x4 t0, t1, t2, t3;
                    if (rope && wc == 0) { const f32x4* tp = (const f32x4*)(tabQ + (pos * 16 + 8 * (fq & 1)) * 2); t0 = tp[0]; t1 = tp[1]; t2 = tp[2]; t3 = tp[3]; }
#pragma unroll
                    for (int bj = 0; bj < 2; ++bj) { f32x4 v0 = acc[ai][bj][m][0], v1 = acc[ai][bj][m][1];
                        if (rope && wc == 0) {
                            const float sg = fq < 2 ? -1.f : 1.f;
                            const float cs[8] = {t0[0], t0[2], t1[0], t1[2], t2[0], t2[2], t3[0], t3[2]}, sn[8] = {t0[1], t0[3], t1[1], t1[3], t2[1], t2[3], t3[1], t3[3]};
#pragma unroll
                            for (int i = 0; i < 4; ++i) { const float p0 = __shfl_xor(v0[i], 32), p1 = __shfl_xor(v1[i], 32);
                                v0[i] = v0[i] * cs[i] + sg * p0 * sn[i]; v1[i] = v1[i] * cs[4 + i] + sg * p1 * sn[4 + i]; } }
                        const v4u w = pack8(v0, v1);
                        if (isq) { *(v4u*)(Q + (size_t)row * QW + (pn - 16) * 256 + bj * 128 + c0) = w; }
                        else { const int kc = ((pn - 24) & 1) * 256 + bj * 128 + c0;
                            bf16* dp = isk ? (samp ? KCAT : KP) : (samp ? VCAT : VP);
                            const int r2 = row - MP;
                            const size_t drow = samp ? (size_t)((r2 >> 5) * LCAT + 2048 + (r2 & 31)) : (size_t)row;
                            *(v4u*)(dp + drow * KVW + kc) = w;
                            float* op = out + (isk ? (samp ? O_KS : O_KP) : (samp ? O_VS : O_VP)) + (size_t)(samp ? r2 : row) * KVW + kc;
                            *(f32x4*)op = v0; *(f32x4*)(op + 4) = v1; } } }
        } else if (pn < 32) {
#pragma unroll
            for (int ai = 0; ai < 2; ++ai)
#pragma unroll
                for (int m = 0; m < 4; ++m) { const int row = row0 + ai * 128 + m * 16; const int pos = samp ? 2048 + (row & 31) : (row & 2047);
                    f32x4 t0, t1, t2, t3;
                    if ((wc & 1) == 0) { const f32x4* tp = (const f32x4*)(tabI + pos * 16); t0 = tp[0]; t1 = tp[1]; t2 = tp[2]; t3 = tp[3]; }
#pragma unroll
                    for (int bj = 0; bj < 2; ++bj) { f32x4 v0 = acc[ai][bj][m][0], v1 = acc[ai][bj][m][1];
                        if ((wc & 1) == 0) {
                            const float sg = fq == 0 ? -1.f : 1.f;
                            const float cs[8] = {t0[0], t0[2], t1[0], t1[2], t2[0], t2[2], t3[0], t3[2]}, sn[8] = {t0[1], t0[3], t1[1], t1[3], t2[1], t2[3], t3[1], t3[3]};
#pragma unroll
                            for (int i = 0; i < 4; ++i) { const float p0 = __shfl_xor(v0[i], 16), p1 = __shfl_xor(v1[i], 16);
                                const float r0 = v0[i] * cs[i] + sg * p0 * sn[i], r1 = v1[i] * cs[4 + i] + sg * p1 * sn[4 + i];
                                v0[i] = fq < 2 ? r0 : v0[i]; v1[i] = fq < 2 ? r1 : v1[i]; } }
                        *(v4u*)(QI + (size_t)row * IDXW + (pn - 28) * 256 + bj * 128 + c0) = pack8(v0, v1); } }
        } else {
#pragma unroll
            for (int ai = 0; ai < 2; ++ai)
#pragma unroll
                for (int m = 0; m < 4; ++m) { const int row = row0 + ai * 128 + m * 16; const int pos = samp ? 2048 + (row & 31) : (row & 2047);
                    f32x4 v0 = acc[ai][0][m][0], v1 = acc[ai][0][m][1];
                    if (wc == 0) {
                        const f32x4* tp = (const f32x4*)(tabI + pos * 16); const f32x4 t0 = tp[0], t1 = tp[1], t2 = tp[2], t3 = tp[3];
                        const float sg = fq == 0 ? -1.f : 1.f;
                        const float cs[8] = {t0[0], t0[2], t1[0], t1[2], t2[0], t2[2], t3[0], t3[2]}, sn[8] = {t0[1], t0[3], t1[1], t1[3], t2[1], t2[3], t3[1], t3[3]};
#pragma unroll
                        for (int i = 0; i < 4; ++i) { const float p0 = __shfl_xor(v0[i], 16), p1 = __shfl_xor(v1[i], 16);
                            const float r0 = v0[i] * cs[i] + sg * p0 * sn[i], r1 = v1[i] * cs[4 + i] + sg * p1 * sn[4 + i];
                            v0[i] = fq < 2 ? r0 : v0[i]; v1[i] = fq < 2 ? r1 : v1[i]; } }
                    if (wc < 2) { const int r2 = row - MP;
                        const size_t drow = samp ? (size_t)((r2 >> 5) * LCAT + 2048 + (r2 & 31)) : (size_t)row;
                        *(v4u*)((samp ? KICAT : KIP) + drow * IDXD + c0) = pack8(v0, v1);
                        float* op = out + (samp ? O_KIS : O_KIP) + (size_t)(samp ? r2 : row) * IDXD + c0;
                        *(f32x4*)op = v0; *(f32x4*)(op + 4) = v1; }
                    else if (wc == 2 && fq < 2) { float* wp = WI + (size_t)row * 16 + 8 * fq; *(f32x4*)wp = v0 * 0.03125f; *(f32x4*)(wp + 4) = v1 * 0.03125f; } }
        }
    }
};

struct ProjOrder : pg8::StaticOrder {
    __device__ __forceinline__ bool next(int i, Unit& u) const { if (!pg8::StaticOrder::next(i, u)) return false; if (u.pn >= 32) u.pn += 1; return true; }
};
struct ThinOrder {
    int c;
    __device__ __forceinline__ bool next(int i, Unit& u) const { if (i > 0 || c >= 204) return false; u.pm = c % 68; u.pn = 32; return true; }
    __device__ __forceinline__ void a_ready(const Unit&) const {}
    __device__ __forceinline__ void done(const Unit&) const {}
};
struct EpiThinPart {
    static constexpr bool PERM = true, AFTER_DRAIN = false;
    float* part;
    __device__ __forceinline__ void operator()(const f32x4 (&acc)[2][2][4][2], const Unit& u, int wr, int wc, int fr, int fq) const {
        const int row0 = u.pm * 256 + wr * 64 + fr, c0 = wc * 32 + 8 * fq;
#pragma unroll
        for (int ai = 0; ai < 2; ++ai)
#pragma unroll
            for (int m = 0; m < 4; ++m) { float* p = part + (size_t)(row0 + ai * 128 + m * 16) * 128 + c0; *(f32x4*)p = acc[ai][0][m][0]; *(f32x4*)(p + 4) = acc[ai][0][m][1]; }
    }
};
struct EpiMergeA {
    static constexpr bool PERM = true, AFTER_DRAIN = false;
    unsigned char* ws; bf16* P;
    __device__ __forceinline__ void operator()(const f32x4 (&acc)[2][2][4][2], const Unit& u, int wr, int wc, int fr, int fq) const {
        const bf16* const SA = (const bf16*)(ws + WS_SA);
        const int row0 = u.pm * 256 + wr * 64 + fr, col0 = u.pn * 256 + wc * 32 + 8 * fq;
#pragma unroll
        for (int ai = 0; ai < 2; ++ai)
#pragma unroll
            for (int m = 0; m < 4; ++m) { const size_t off = (size_t)(row0 + ai * 128 + m * 16) * DM + col0;
#pragma unroll
                for (int bj = 0; bj < 2; ++bj) { const v4u g = *(const v4u*)(SA + off + bj * 128); const f32x4 a0 = acc[ai][bj][m][0], a1 = acc[ai][bj][m][1];
                    const f32x4 y0 = {a0[0] * bf_lo(g.x), a0[1] * bf_hi(g.x), a0[2] * bf_lo(g.y), a0[3] * bf_hi(g.y)};
                    const f32x4 y1 = {a1[0] * bf_lo(g.z), a1[1] * bf_hi(g.z), a1[2] * bf_lo(g.w), a1[3] * bf_hi(g.w)};
                    *(v4u*)(P + off + bj * 128) = pack8(y0, y1); } }
    }
};
struct EpiMergeB {
    static constexpr bool PERM = true, AFTER_DRAIN = false;
    unsigned char* ws; const bf16* P;
    __device__ __forceinline__ void operator()(const f32x4 (&acc)[2][2][4][2], const Unit& u, int wr, int wc, int fr, int fq) const {
        const bf16* const SB = (const bf16*)(ws + WS_SB); bf16* const Y = (bf16*)(ws + WS_H);
        const int row0 = u.pm * 256 + wr * 64 + fr, col0 = u.pn * 256 + wc * 32 + 8 * fq;
#pragma unroll
        for (int ai = 0; ai < 2; ++ai)
#pragma unroll
            for (int m = 0; m < 4; ++m) { const size_t off = (size_t)(row0 + ai * 128 + m * 16) * DM + col0;
#pragma unroll
                for (int bj = 0; bj < 2; ++bj) { const v4u g = *(const v4u*)(SB + off + bj * 128); const v4u p = *(const v4u*)(P + off + bj * 128);
                    const f32x4 a0 = acc[ai][bj][m][0], a1 = acc[ai][bj][m][1];
                    const f32x4 y0 = {bf_lo(p.x) + a0[0] * bf_lo(g.x), bf_hi(p.x) + a0[1] * bf_hi(g.x), bf_lo(p.y) + a0[2] * bf_lo(g.y), bf_hi(p.y) + a0[3] * bf_hi(g.y)};
                    const f32x4 y1 = {bf_lo(p.z) + a1[0] * bf_lo(g.z), bf_hi(p.z) + a1[1] * bf_hi(g.z), bf_lo(p.w) + a1[2] * bf_lo(g.w), bf_hi(p.w) + a1[3] * bf_hi(g.w)};
                    *(v4u*)(Y + off + bj * 128) = pack8(y0, y1); } }
    }
};
__device__ __forceinline__ int perm_row(int p) { const int id = p >> 3, off = p & 7; return 128 * (off >> 2) + 64 * (id >> 4) + 16 * (off & 3) + (id & 15); }
struct EpiX1 {
    static constexpr bool PERM = true, AFTER_DRAIN = false;
    unsigned char* ws; KA* ka;
    __device__ __forceinline__ void operator()(const f32x4 (&acc)[2][2][4][2], const Unit& u, int wr, int wc, int fr, int fq) const {
        bf16* const X1B = (bf16*)(ws + WS_X1B); float* const ssq2 = (float*)(ws + WS_CTL) + CW_SSQ2;
        const float* const x = in_ptr(ka, 0);
        const int col0 = u.pn * 256 + wc * 32 + 8 * fq;
#pragma unroll
        for (int ai = 0; ai < 2; ++ai)
#pragma unroll
            for (int m = 0; m < 4; ++m) { const int p = ai * 128 + wr * 64 + m * 16 + fr, row = u.pm * 256 + p; float s = 0.f;
                const float* xr = x + (size_t)row * DM + col0; bf16* dr = X1B + (size_t)(u.pm * 256 + perm_row(p)) * DM + col0;
#pragma unroll
                for (int bj = 0; bj < 2; ++bj) { const f32x4 v0 = *(const f32x4*)(xr + bj * 128) + acc[ai][bj][m][0], v1 = *(const f32x4*)(xr + bj * 128 + 4) + acc[ai][bj][m][1];
                    s += (v0[0] * v0[0] + v0[1] * v0[1]) + (v0[2] * v0[2] + v0[3] * v0[3]) + (v1[0] * v1[0] + v1[1] * v1[1]) + (v1[2] * v1[2] + v1[3] * v1[3]);
                    *(v4u*)(dr + bj * 128) = pack8(v0, v1); }
                s += __shfl_xor(s, 16); s += __shfl_xor(s, 32);
                if (fq == 0) __hip_atomic_fetch_add(ssq2 + row, s, RLX_AGENT); }
    }
};
struct EpiX2 {
    static constexpr bool PERM = true, AFTER_DRAIN = false;
    unsigned char* ws;
    __device__ __forceinline__ void operator()(const f32x4 (&acc)[2][2][4][2], const Unit& u, int wr, int wc, int fr, int fq) const {
        const bf16* const X1B = (const bf16*)(ws + WS_X1B); bf16* const X2B = (bf16*)(ws + WS_X2B);
        const int col0 = u.pn * 256 + wc * 32 + 8 * fq;
#pragma unroll
        for (int ai = 0; ai < 2; ++ai)
#pragma unroll
            for (int m = 0; m < 4; ++m) { const int p = ai * 128 + wr * 64 + m * 16 + fr;
                const bf16* sr = X1B + (size_t)(u.pm * 256 + perm_row(p)) * DM + col0; bf16* dr = X2B + (size_t)(u.pm * 256 + p) * DM + col0;
#pragma unroll
                for (int bj = 0; bj < 2; ++bj) { const v4u x = *(const v4u*)(sr + bj * 128); const f32x4 a0 = acc[ai][bj][m][0], a1 = acc[ai][bj][m][1];
                    const f32x4 v0 = {bf_lo(x.x) + a0[0], bf_hi(x.x) + a0[1], bf_lo(x.y) + a0[2], bf_hi(x.y) + a0[3]};
                    const f32x4 v1 = {bf_lo(x.z) + a1[0], bf_hi(x.z) + a1[1], bf_lo(x.w) + a1[2], bf_hi(x.w) + a1[3]};
                    *(v4u*)(dr + bj * 128) = pack8(v0, v1); } }
    }
};
constexpr int UP_SLOT = 5120;
struct UpOrder : pg8::StaticOrder {
    unsigned char* ws; KA* ka; LAS unsigned char* par; mutable int k;
    gu32* ctl; volatile LAS unsigned* pfw; mutable int lastchunk; int dyn, x, j, ch, nch;
    __device__ __forceinline__ void initd(gu32* ctl_, volatile LAS unsigned* pfw_) { ctl = ctl_; pfw = pfw_; dyn = (G & 7) == 0 && G >= 8; x = c & 7; j = c >> 3; ch = G >> 3; nch = dyn ? (nwg + ch - 1) / ch : 0; lastchunk = 0; }
    __device__ __forceinline__ bool next(int i, Unit& u) const {
        if (!dyn) return pg8::StaticOrder::next(i, u);
        if (i >= 3 && lastchunk >= nch - 1) return false;
        const int tid = (int)threadIdx.x;
        gu32* cl = ctl + CW_CL + x * 256;
        if (i + 2 >= 3 && (i + 2) % ch == j && tid == 0) {
            if (i + 1 >= 3) while ((__hip_atomic_load(cl + i + 1, RLX_AGENT) >> 16) != (unsigned)(i + 1)) __builtin_amdgcn_s_sleep(1);
            const unsigned v = __hip_atomic_fetch_add(ctl + CW_DQ, 1u, RLX_AGENT);
            __hip_atomic_store(cl + i + 2, ((unsigned)(i + 2) << 16) | (24u + v + 1u), RLX_AGENT);
            asm volatile("s_waitcnt vmcnt(0)" ::: "memory");
        }
        int chunk;
        if (i < 3) chunk = 8 * i + x;
        else { unsigned v = pfw[i & 1];
            while ((v >> 16) != (unsigned)i) { v = __hip_atomic_load(cl + i, RLX_AGENT); if ((v >> 16) != (unsigned)i) __builtin_amdgcn_s_sleep(1); }
            chunk = (int)(v & 0xffffu) - 1; }
        chunk = __builtin_amdgcn_readfirstlane(chunk);
        lastchunk = chunk;
        if (i + 1 >= 3 && tid == 0) __builtin_amdgcn_global_load_lds((const unsigned*)(cl + i + 1), (LAS unsigned*)(pfw + ((i + 1) & 1)), 4, 0, 17);
        const int wgid = ch * chunk + j;
        if (chunk >= nch || wgid >= nwg) return false;
        const int nig = pg8::WGM * nN, gid = wgid / nig, fm = gid * pg8::WGM, gsz = (nM - fm) < pg8::WGM ? (nM - fm) : pg8::WGM;
        u.pm = fm + ((wgid % nig) % gsz); u.pn = (wgid % nig) / gsz; return true;
    }
    __device__ __forceinline__ void a_ready(const Unit& u) const {
        const int wid = __builtin_amdgcn_readfirstlane((int)threadIdx.x >> 6), lane = (int)threadIdx.x & 63;
        LAS unsigned char* slot = par + (k & 1) * UP_SLOT; ++k;
        if (wid < 4) { const int arr = 2 * wid + (lane >> 5), col = 4 * (lane & 31);
            const float* base = (arr & 3) < 3 ? in_ptr(ka, 16) + (size_t)(arr & 3) * NUP : in_ptr(ka, 17);
            __builtin_amdgcn_global_load_lds((const unsigned*)(base + ((arr >> 2) ? DFF : 0) + 128 * u.pn + col), (LAS unsigned*)(slot + wid * 1024), 16, 0, 0); }
        else if (wid == 4) __builtin_amdgcn_global_load_lds((const unsigned*)((const float*)(ws + WS_CTL) + CW_SSQ2 + 256 * u.pm + 4 * lane), (LAS unsigned*)(slot + 4096), 16, 0, 0);
    }
};
struct EpiUp {
    static constexpr bool PERM = true, AFTER_DRAIN = false;
    unsigned char* ws; float* out; KA* ka; LAS unsigned char* par; mutable int k;
    __device__ __forceinline__ void operator()(const f32x4 (&acc)[2][2][4][2], const Unit& u, int wr, int wc, int fr, int fq) const {
        bf16* const ACT = (bf16*)(ws + WS_ACT); float* const ZF = (float*)(ws + WS_H); float* const ZL = ZF + (size_t)128 * 2 * NUP;
        const float* const state = in_ptr(ka, 5);
        const LAS float* const PR = (const LAS float*)(par + (k & 1) * UP_SLOT); ++k;
        const int pm = u.pm, pn = u.pn, id = wr * 16 + fr, beta = 2 * pm + wr;
        const bool samp = pm >= 64;
        {
            f32x4 (&a)[2][2][4][2] = const_cast<f32x4 (&)[2][2][4][2]>(acc);
            const LAS float* sq = PR + 1024 + 8 * id;
#pragma unroll
            for (int ai = 0; ai < 2; ++ai)
#pragma unroll
                for (int m = 0; m < 4; ++m) { const float r = __builtin_amdgcn_rsqf(sq[4 * ai + m] * (1.f / DM) + EPS);
#pragma unroll
                    for (int bj = 0; bj < 2; ++bj)
#pragma unroll
                        for (int n = 0; n < 2; ++n) { a[ai][bj][m][n] *= r; asm volatile("" : "+v"(a[ai][bj][m][n])); } }
            asm volatile("" ::: "memory"); }
        const int bs = 8 * (pm - 64) + (id >> 2);
#pragma unroll
        for (int n = 0; n < 2; ++n) {
            const int cl = wc * 32 + 8 * fq + 4 * n, cg = pn * 128 + cl, cu = DFF + cg;
            const f32x4 w0g = *(const LAS f32x4*)(PR + cl), w1g = *(const LAS f32x4*)(PR + 128 + cl), w2g = *(const LAS f32x4*)(PR + 256 + cl), bg = *(const LAS f32x4*)(PR + 384 + cl);
            const f32x4 w0u = *(const LAS f32x4*)(PR + 512 + cl), w1u = *(const LAS f32x4*)(PR + 640 + cl), w2u = *(const LAS f32x4*)(PR + 768 + cl), bu = *(const LAS f32x4*)(PR + 896 + cl);
            const f32x4 g6 = acc[1][0][2][n], g7 = acc[1][0][3][n], u6 = acc[1][1][2][n], u7 = acc[1][1][3][n];
            f32x4 pg2, pg1, pu2, pu1;
#pragma unroll
            for (int i = 0; i < 4; ++i) { pg2[i] = __shfl_up(g6[i], 1); pg1[i] = __shfl_up(g7[i], 1); pu2[i] = __shfl_up(u6[i], 1); pu1[i] = __shfl_up(u7[i], 1); }
            bool defer = false;
            if (!samp) {
                if (fr == 0) {
                    if ((beta & 15) == 0) { pg2 = (f32x4){0.f, 0.f, 0.f, 0.f}; pg1 = pg2; pu2 = pg2; pu1 = pg2; }
                    else { defer = true; float* zf = ZF + (size_t)beta * 2 * NUP;
                        *(f32x4*)(zf + cg) = acc[0][0][0][n]; *(f32x4*)(zf + NUP + cg) = acc[0][0][1][n]; *(f32x4*)(zf + cu) = acc[0][1][0][n]; *(f32x4*)(zf + NUP + cu) = acc[0][1][1][n]; }
                }
                if (fr == 15) { float* zl = ZL + (size_t)beta * 2 * NUP;
                    *(f32x4*)(zl + cg) = g6; *(f32x4*)(zl + NUP + cg) = g7; *(f32x4*)(zl + cu) = u6; *(f32x4*)(zl + NUP + cu) = u7;
                    if ((beta & 15) == 15) { float* op = out + O_CP + (size_t)(beta >> 4) * 2 * NUP;
                        *(f32x4*)(op + cg) = g6; *(f32x4*)(op + NUP + cg) = g7; *(f32x4*)(op + cu) = u6; *(f32x4*)(op + NUP + cu) = u7; } }
            } else {
                if ((fr & 3) == 0) { const float* sp = state + (size_t)bs * 2 * NUP;
                    pg2 = *(const f32x4*)(sp + cg); pg1 = *(const f32x4*)(sp + NUP + cg); pu2 = *(const f32x4*)(sp + cu); pu1 = *(const f32x4*)(sp + NUP + cu); }
                if ((fr & 3) == 3) { float* op = out + O_CS + (size_t)bs * 2 * NUP;
                    *(f32x4*)(op + cg) = g6; *(f32x4*)(op + NUP + cg) = g7; *(f32x4*)(op + cu) = u6; *(f32x4*)(op + NUP + cu) = u7; }
            }
            bf16* ap = ACT + (size_t)(pm * 256 + 8 * id) * DFF + cg;
#pragma unroll
            for (int off = 0; off < 8; ++off) {
                const f32x4 zg = acc[off >> 2][0][off & 3][n], zu = acc[off >> 2][1][off & 3][n];
                const f32x4 zg1 = off >= 1 ? acc[(off + 7) >> 2 & 1][0][(off + 7) & 3][n] : pg1, zu1 = off >= 1 ? acc[(off + 7) >> 2 & 1][1][(off + 7) & 3][n] : pu1;
                const f32x4 zg2 = off >= 2 ? acc[(off + 6) >> 2 & 1][0][(off + 6) & 3][n] : (off == 1 ? pg1 : pg2), zu2 = off >= 2 ? acc[(off + 6) >> 2 & 1][1][(off + 6) & 3][n] : (off == 1 ? pu1 : pu2);
                const f32x4 c_g = bg + w0g * zg2 + w1g * zg1 + w2g * zg, c_u = bu + w0u * zu2 + w1u * zu1 + w2u * zu;
                f32x4 a;
#pragma unroll
                for (int i = 0; i < 4; ++i) a[i] = c_g[i] * sigmoidf_(c_g[i]) * c_u[i];
                v2u w; w.x = cvt_pk_bf16(a[0], a[1]); w.y = cvt_pk_bf16(a[2], a[3]);
                if (!(defer && off < 2)) *(v2u*)(ap + (size_t)off * DFF) = w;
            }
            asm volatile("" ::: "memory");
        }
    }
};

struct EpiNull {
    static constexpr bool PERM = true, AFTER_DRAIN = false;
    __device__ __forceinline__ void operator()(const f32x4 (&acc)[2][2][4][2], const Unit& u, int wr, int wc, int fr, int fq) const {
#pragma unroll
        for (int ai = 0; ai < 2; ++ai)
#pragma unroll
            for (int bj = 0; bj < 2; ++bj)
#pragma unroll
                for (int m = 0; m < 4; ++m)
#pragma unroll
                    for (int n = 0; n < 2; ++n) asm volatile("" :: "v"(acc[ai][bj][m][n]));
    }
};

struct RemOrder {
    int c;
    __device__ __forceinline__ bool next(int i, Unit& u) const { if (i > 0) return false; u.pm = 64 + ((c & 63) >> 4); u.pn = c & 15; return true; }
    __device__ __forceinline__ void a_ready(const Unit&) const {}
    __device__ __forceinline__ void done(const Unit&) const {}
};
struct EpiPart {
    static constexpr bool PERM = false, AFTER_DRAIN = false;
    float* part;
    __device__ __forceinline__ void operator()(const f32x4 (&acc)[2][2][4][2], const Unit& u, int wr, int wc, int fr, int fq) const {
        const int row0 = (u.pm - 64) * 256 + wr * 64 + fr, col0 = u.pn * 256 + wc * 32 + 4 * fq;
#pragma unroll
        for (int ai = 0; ai < 2; ++ai)
#pragma unroll
            for (int m = 0; m < 4; ++m) { const size_t off = (size_t)(row0 + ai * 128 + m * 16) * DM + col0;
#pragma unroll
                for (int bj = 0; bj < 2; ++bj)
#pragma unroll
                    for (int n = 0; n < 2; ++n) *(f32x4*)(part + off + bj * 128 + n * 16) = acc[ai][bj][m][n]; }
    }
};

constexpr int VT_PITCH = 272;
__device__ __forceinline__ void gmlp_item(Frame& F, int item, bool dry = false) {
    const bool samp = item >= 1024;
    int tid_ = F.tid; asm volatile("" : "+v"(tid_));
    const int tid = tid_, lane = tid & 63;
    const int g = item & 7;
    const int row0 = samp ? MP + 32 * ((item - 1024) >> 3) : 128 * (item >> 3);
    LAS unsigned char* VT = F.lds;
    const bf16* Vb = WSP(bf16, WS_V); const bf16* Ub = WSP(bf16, WS_U); bf16* Ob = dry ? (bf16*)F.out : WSP(bf16, WS_U);
    const float* ssq = (const float*)(F.ctl + CW_SSQ);
    const float* gn = INP(8);
    { const int JB = samp ? 32 : 128, j = tid & (JB - 1), cq = samp ? (tid >> 5) : (tid >> 7), ncq = samp ? 16 : 4, npass = 32 / ncq;
      const int row = row0 + j;
      const float rs = 1.f / sqrtf(ssq[row] * (1.f / DA) + EPS);
      v4u vv[8];
#pragma unroll
      for (int p = 0; p < 8; ++p) if (p < npass) vv[p] = *(const v4u*)(Vb + (size_t)row * DA + 256 * g + 8 * (cq + ncq * p));
#pragma unroll
      for (int p = 0; p < 8; ++p) { if (p >= npass) break; const int c8 = cq + ncq * p, col = 256 * g + 8 * c8;
          const v4u v = vv[p];
          const f32x4 g0 = *(const f32x4*)(gn + col), g1 = *(const f32x4*)(gn + col + 4);
          float x[8] = {bf_lo(v.x) * rs * g0[0], bf_hi(v.x) * rs * g0[1], bf_lo(v.y) * rs * g0[2], bf_hi(v.y) * rs * g0[3], bf_lo(v.z) * rs * g1[0], bf_hi(v.z) * rs * g1[1], bf_lo(v.w) * rs * g1[2], bf_hi(v.w) * rs * g1[3]};
          if (samp) { float* op = F.out + O_GV + (size_t)(row - MP) * DA + col; *(f32x4*)op = (f32x4){x[0], x[1], x[2], x[3]}; *(f32x4*)(op + 4) = (f32x4){x[4], x[5], x[6], x[7]}; }
#pragma unroll
          for (int e = 0; e < 8; ++e) *(LAS bf16*)(VT + (8 * c8 + e) * VT_PITCH + 2 * j) = f2bf1(x[e]); } }
    __syncthreads();
    const int li = lane & 15, lq = lane >> 4;
    f32x4 acc[2][8];
#pragma unroll
    for (int db = 0; db < 2; ++db)
#pragma unroll
        for (int ib = 0; ib < 8; ++ib) acc[db][ib] = (f32x4){0.f, 0.f, 0.f, 0.f};
    bf16x8 af[2][4];
#pragma unroll
    for (int db = 0; db < 2; ++db)
#pragma unroll
        for (int ks = 0; ks < 4; ++ks) af[db][ks] = *(const LAS bf16x8*)(VT + (32 * F.wave + 16 * db + li) * VT_PITCH + (32 * ks + 8 * lq) * 2);
    const bf16* Wg = WSP(bf16, WS_WSB) + (size_t)g * 128 * 128;
#pragma unroll
    for (int ib = 0; ib < 8; ++ib) {
        if (samp && ib >= 2) continue;
#pragma unroll
        for (int ks = 0; ks < 4; ++ks) {
            if (ks >= (ib < 4 ? 2 : 4)) continue;
            if (samp && ks >= 1) continue;
            const bf16x8 bfr = *(const bf16x8*)(Wg + (16 * ib + li) * 128 + 32 * ks + 8 * lq);
#pragma unroll
            for (int db = 0; db < 2; ++db) acc[db][ib] = __builtin_amdgcn_mfma_f32_16x16x32_bf16(af[db][ks], bfr, acc[db][ib], 0, 0, 0);
        }
    }
    const float* gb = INP(10) + g * 128;
#pragma unroll
    for (int ib = 0; ib < 8; ++ib) {
        if (samp && ib >= 2) continue;
        const int i = 16 * ib + li; const float bias = gb[i];
#pragma unroll
        for (int db = 0; db < 2; ++db) { const size_t uo = (size_t)(row0 + i) * DA + 256 * g + 32 * F.wave + 16 * db + 4 * lq; bf16* up = Ob + uo;
            const v2u uu = *(const v2u*)(Ub + uo); const f32x4 s = acc[db][ib];
            v2u w; w.x = cvt_pk_bf16(bf_lo(uu.x) * (s[0] + bias), bf_hi(uu.x) * (s[1] + bias)); w.y = cvt_pk_bf16(bf_lo(uu.y) * (s[2] + bias), bf_hi(uu.y) * (s[3] + bias));
            *(v2u*)up = w; }
    }
}

template <int NTL>
__device__ __forceinline__ unsigned long long select_query(const float* srow, int lane, int nvalid) {
    int nvq = nvalid; asm volatile("" : "+s"(nvq));
    int ln = lane; asm volatile("" : "+v"(ln));
    const float* slane = srow + ln;
    unsigned key[NTL];
#pragma unroll
    for (int i = 0; i < NTL; ++i) { float v = slane[64 * i]; v = (64 * i + ln < nvq) ? v : -__builtin_inff();
        const unsigned ub = __float_as_uint(v); key[i] = (ub & 0x80000000u) ? ~ub : (ub | 0x80000000u); }
    unsigned T = 0u; bool exact = false;
    for (int bit = 31; bit >= 0; --bit) {
        const unsigned cand = T | (1u << bit); int cnt = 0;
#pragma unroll
        for (int i = 0; i < NTL; ++i) { cnt += __builtin_popcountll(__ballot(key[i] >= cand)); if ((i & 3) == 3) __builtin_amdgcn_sched_barrier(0); }
        if (cnt >= 256) { T = cand; if (cnt == 256) { exact = true; break; } }
    }
    unsigned long long myw = 0ull;
    if (exact) {
#pragma unroll
        for (int i = 0; i < NTL; ++i) { const unsigned long long mm = __ballot(key[i] >= T); if (ln == i) myw = mm; if ((i & 3) == 3) __builtin_amdgcn_sched_barrier(0); }
    } else {
        int cgt = 0;
#pragma unroll 1
        for (int i = 0; i < NTL; ++i) { float v = slane[64 * i]; v = (64 * i + ln < nvq) ? v : -__builtin_inff(); const unsigned ub = __float_as_uint(v); const unsigned k = (ub & 0x80000000u) ? ~ub : (ub | 0x80000000u);
            cgt += __builtin_popcountll(__ballot(k > T)); }
        int need = 256 - cgt;
#pragma unroll 1
        for (int i = 0; i < NTL; ++i) { float v = slane[64 * i]; v = (64 * i + ln < nvq) ? v : -__builtin_inff(); const unsigned ub = __float_as_uint(v); const unsigned k = (ub & 0x80000000u) ? ~ub : (ub | 0x80000000u);
            const unsigned long long mgt = __ballot(k > T); unsigned long long meq = __ballot(k == T); int ce = __builtin_popcountll(meq);
            while (ce > need) { meq &= ~(1ull << (63 - __builtin_clzll(meq))); --ce; }
            need -= ce; const unsigned long long mm = mgt | meq; if (ln == i) myw = mm; }
    }
    return myw;
}
__device__ __forceinline__ void idx_item(Frame& F, int it) {
    bool samp = false; int b, c, qh = 0;
    if (it < 128) { c = 31 - (it >> 4); b = (it >> 1) & 7; qh = it & 1; }
    else if (it < 160) { samp = true; c = 32; b = it - 128; }
    else if (it < 480) { const int k = it - 160; c = 23 - (k >> 4); b = (k >> 1) & 7; qh = k & 1; }
    else { const int k = it - 480; c = k >> 3; b = k & 7; }
    unsigned long long* MASK = WSP(unsigned long long, WS_MASK);
    if (it >= 480) {
        const int ntp4 = (c + 2) & ~1, R0 = 2048 * b + 64 * c;
        for (int i = F.tid; i < 64 * ntp4; i += NTHREADS) { const int q = i / ntp4, t = i - q * ntp4; MASK[(size_t)(R0 + q) * MTILES + t] = (t <= c) ? ~0ull : 0ull; }
        return;
    }
    const int Rq0 = samp ? MP + 32 * b : 2048 * b + 64 * c + 32 * qh;
    const int ntile = samp ? 33 : c + 1;
    const int ntp = samp ? 34 : ((c + 2) & ~1);
    float* SC = WSP(float, WS_H) + (size_t)blockIdx.x * 32 * SCW;
    const bf16* KI = samp ? WSP(bf16, WS_KICAT) + (size_t)b * LCAT * IDXD : WSP(bf16, WS_KIP) + (size_t)b * 2048 * IDXD;
    const bf16* QIb = WSP(bf16, WS_QI); const float* WIb = WSP(float, WS_WI);
    int l_ = F.lane; asm volatile("" : "+v"(l_));
    const int r32 = l_ & 31, hi = l_ >> 5;
    const int nkb = samp ? 65 : 2 * (c + 1);
    constexpr int QL_PITCH = 2064;
    static_assert(32 * QL_PITCH + 2048 <= LDSCTL_OFF, "q_idx image + w_idx rows fit under the LDS control words");
    LAS unsigned char* QL = F.lds;
    { int t_ = F.tid; asm volatile("" : "+v"(t_));
      for (int i = t_; i < 32 * 128; i += NTHREADS) { const int q = i >> 7, ch = i & 127; *(LAS v4u*)(QL + q * QL_PITCH + ch * 16) = *(const v4u*)(QIb + (size_t)(Rq0 + q) * IDXW + ch * 8); }
      if (t_ < 128) *(LAS v4u*)(QL + 32 * QL_PITCH + t_ * 16) = *(const v4u*)(WIb + (size_t)Rq0 * 16 + t_ * 4); }
    __syncthreads();
    const LAS unsigned char* qp = QL + r32 * QL_PITCH + 16 * hi;
    const LAS float* wl = (const LAS float*)(QL + 32 * QL_PITCH) + r32 * 16;
    bf16x8 kn[4];
    { const bf16* kp = KI + (size_t)(32 * F.wave + r32) * IDXD + 8 * hi;
#pragma unroll
      for (int s = 0; s < 4; ++s) kn[s] = *(const bf16x8*)(kp + 16 * s); }
    for (int kb = F.wave; kb < nkb; kb += NWAVES) {
        bf16x8 kf[4];
#pragma unroll
        for (int s = 0; s < 4; ++s) kf[s] = kn[s];
        if (kb + NWAVES < nkb) { const bf16* kp = KI + (size_t)(32 * (kb + NWAVES) + r32) * IDXD + 8 * hi;
#pragma unroll
            for (int s = 0; s < 4; ++s) kn[s] = *(const bf16x8*)(kp + 16 * s); }
        f32x16 sc;
#pragma unroll
        for (int r = 0; r < 16; ++r) sc[r] = 0.f;
#pragma unroll
        for (int h = 0; h < 16; ++h) {
            bf16x8 qf[4];
#pragma unroll
            for (int s = 0; s < 4; ++s) qf[s] = *(const LAS bf16x8*)(qp + 128 * h + 32 * s);
            f32x16 C;
#pragma unroll
            for (int r = 0; r < 16; ++r) C[r] = 0.f;
#pragma unroll
            for (int s = 0; s < 4; ++s) C = __builtin_amdgcn_mfma_f32_32x32x16_bf16(kf[s], qf[s], C, 0, 0, 0);
            const float wh = wl[h];
#pragma unroll
            for (int r = 0; r < 16; ++r) sc[r] = __builtin_fmaf(wh, __builtin_amdgcn_fmed3f(C[r], 0.f, __builtin_inff()), sc[r]);
            asm volatile("" : "+v"(sc));
            if (h & 1) __builtin_amdgcn_sched_barrier(0);
        }
        float* sp = SC + (size_t)r32 * SCW + 32 * kb + 4 * hi;
#pragma unroll
        for (int gq = 0; gq < 4; ++gq) *(f32x4*)(sp + 8 * gq) = (f32x4){sc[4 * gq], sc[4 * gq + 1], sc[4 * gq + 2], sc[4 * gq + 3]};
    }
    VM_WAIT(); __syncthreads();
    const int nvalid = samp ? 2080 : 64 * (c + 1);
    for (int qq = F.wave; qq < 32; qq += NWAVES) {
        const float* srow = SC + (size_t)qq * SCW;
        unsigned long long myw;
        if (ntile <= 9) myw = select_query<9>(srow, F.lane, nvalid);
        else if (ntile <= 17) myw = select_query<17>(srow, F.lane, nvalid);
        else if (ntile <= 25) myw = select_query<25>(srow, F.lane, nvalid);
        else myw = select_query<33>(srow, F.lane, nvalid);
        if (F.lane < ntp) MASK[(size_t)(Rq0 + qq) * MTILES + F.lane] = myw;
    }
}

namespace att {
constexpr int D = 128, KVBLK = 64;
constexpr float SCALE = 0.088388347648318440f;
constexpr float THR = 8.f;
constexpr int LDK = KVW;
constexpr size_t SHM_V = KVBLK * D * 2, SHM_K = KVBLK * D * 2;
constexpr int OFF_WS = 2 * SHM_V + 2 * SHM_K, OFF_MK = OFF_WS + NWAVES * 64 * 4;
#define KSWZ(row, colB) ((row) * 256 + ((colB) ^ (((row) & 7) << 4)))
#define SBAR() __builtin_amdgcn_sched_barrier(0)
__device__ __forceinline__ int crow(int r, int hi) { return (r & 3) + 8 * (r >> 2) + 4 * hi; }
__device__ __forceinline__ unsigned cvtpk(float lo, float hi) { unsigned r; asm volatile("v_cvt_pk_bf16_f32 %0, %1, %2" : "=v"(r) : "v"(lo), "v"(hi)); return r; }
__device__ __forceinline__ void partialSM(f32x16& p0, f32x16& p1, float& m_reg, float& mn, float& alpha) {
  constexpr float C = SCALE * 1.4426950408889634f;
  float pmax = p0[0];
#pragma unroll
  for (int r = 1; r < 16; ++r) pmax = fmaxf(pmax, p0[r]);
#pragma unroll
  for (int r = 0; r < 16; ++r) pmax = fmaxf(pmax, p1[r]);
  { auto rr = __builtin_amdgcn_permlane32_swap(__float_as_uint(pmax), __float_as_uint(pmax), false, false);
    pmax = fmaxf(__uint_as_float(rr[0]), __uint_as_float(rr[1])); }
  if (__builtin_expect(__all(pmax - m_reg <= THR / SCALE), 1)) { mn = m_reg; alpha = 1.f; }
  else { mn = fmaxf(m_reg, pmax); alpha = __builtin_amdgcn_exp2f((m_reg - mn) * C); m_reg = mn; }
  float mnC = -mn * C;
#pragma unroll
  for (int r = 0; r < 16; ++r) p0[r] = fmaf(p0[r], C, mnC);
#pragma unroll
  for (int r = 0; r < 16; ++r) p1[r] = fmaf(p1[r], C, mnC);
#pragma unroll
  for (int r = 0; r < 16; ++r) p0[r] = __builtin_amdgcn_exp2f(p0[r]);
}
__device__ __forceinline__ void finishSM(f32x16& p0, f32x16& p1, float alpha, float& l_reg, bf16x8& pa0, bf16x8& pa1, bf16x8& pa2, bf16x8& pa3) {
#pragma unroll
  for (int r = 0; r < 16; ++r) p1[r] = __builtin_amdgcn_exp2f(p1[r]);
  float ps = 0;
#pragma unroll
  for (int r = 0; r < 16; ++r) ps += p0[r];
#pragma unroll
  for (int r = 0; r < 16; ++r) ps += p1[r];
  { auto rr = __builtin_amdgcn_permlane32_swap(__float_as_uint(ps), __float_as_uint(ps), false, false);
    ps = __uint_as_float(rr[0]) + __uint_as_float(rr[1]); }
  l_reg = l_reg * alpha + ps;
#define PK4(P, BASE, OUT) do { unsigned a0 = cvtpk(P[BASE + 0], P[BASE + 1]), a1 = cvtpk(P[BASE + 2], P[BASE + 3]);   \
    unsigned b0 = cvtpk(P[BASE + 4], P[BASE + 5]), b1 = cvtpk(P[BASE + 6], P[BASE + 7]);                              \
    auto r0 = __builtin_amdgcn_permlane32_swap(a0, b0, false, false); auto r1 = __builtin_amdgcn_permlane32_swap(a1, b1, false, false); \
    v4u w = {r0[0], r1[0], r0[1], r1[1]}; OUT = *reinterpret_cast<bf16x8*>(&w); } while (0)
  PK4(p0, 0, pa0); PK4(p0, 8, pa1); PK4(p1, 0, pa2); PK4(p1, 8, pa3);
#undef PK4
}
__device__ __forceinline__ void qkt(f32x16& p0, f32x16& p1, const LAS unsigned char* Ks, const bf16x8* qr, int r32, int hi, unsigned long long mw) {
#pragma unroll
  for (int r = 0; r < 16; ++r) { p0[r] = 0.f; p1[r] = 0.f; }
#pragma unroll
  for (int d0 = 0; d0 < 8; ++d0) { int cb = (d0 * 16 + hi * 8) * 2;
    bf16x8 b0 = *reinterpret_cast<const LAS bf16x8*>(Ks + KSWZ(r32, cb));
    bf16x8 b1 = *reinterpret_cast<const LAS bf16x8*>(Ks + KSWZ(32 + r32, cb));
    p0 = __builtin_amdgcn_mfma_f32_32x32x16_bf16(b0, qr[d0], p0, 0, 0, 0);
    p1 = __builtin_amdgcn_mfma_f32_32x32x16_bf16(b1, qr[d0], p1, 0, 0, 0); }
  const unsigned lo = (unsigned)mw >> (4 * hi), hw = (unsigned)(mw >> 32) >> (4 * hi);
  const float ninf = -__builtin_inff();
#pragma unroll
  for (int r = 0; r < 16; ++r) { const int bit = (r & 3) + 8 * (r >> 2); p0[r] = ((lo >> bit) & 1u) ? p0[r] : ninf; p1[r] = ((hw >> bit) & 1u) ? p1[r] : ninf; }
}
__device__ __forceinline__ int v_st(int k, int c) { const int kk = (k & ~0xC) | ((k & 4) << 1) | ((k & 8) >> 1); return ((kk >> 3) * 4 + (c >> 5)) * 512 + ((kk & 7) * 32 + (c & 31)) * 2; }
__device__ __forceinline__ int v_rd_base(int lane) { return ((lane & 3) << 3) | (((lane >> 2) & 3) << 6) | (((lane >> 4) & 1) << 5) | (((lane >> 5) & 1) << 8); }
constexpr int v_rd_off(int d0, int ks, int half) { return d0 * 512 + ks * 4096 + half * 2048; }
template <int OFF> __device__ __forceinline__ s16x4 tr_read(int vb) {
  s16x4 r; asm volatile("ds_read_b64_tr_b16 %0, %1 offset:%2" : "=&v"(r) : "v"(vb), "i"(OFF) : "memory"); return r;
}
template <int D0> __device__ __forceinline__ void pv_one(f32x16& od, int vb, bf16x8 pa0, bf16x8 pa1, bf16x8 pa2, bf16x8 pa3) {
  const s16x4 l0 = tr_read<v_rd_off(D0, 0, 0)>(vb), h0 = tr_read<v_rd_off(D0, 0, 1)>(vb), l1 = tr_read<v_rd_off(D0, 1, 0)>(vb), h1 = tr_read<v_rd_off(D0, 1, 1)>(vb);
  const s16x4 l2 = tr_read<v_rd_off(D0, 2, 0)>(vb), h2 = tr_read<v_rd_off(D0, 2, 1)>(vb), l3 = tr_read<v_rd_off(D0, 3, 0)>(vb), h3 = tr_read<v_rd_off(D0, 3, 1)>(vb);
  asm volatile("s_waitcnt lgkmcnt(0)" ::: "memory"); SBAR();
#define PK(L, H) (bf16x8){L[0], L[1], L[2], L[3], H[0], H[1], H[2], H[3]}
  od = __builtin_amdgcn_mfma_f32_32x32x16_bf16(pa0, PK(l0, h0), od, 0, 0, 0);
  od = __builtin_amdgcn_mfma_f32_32x32x16_bf16(pa1, PK(l1, h1), od, 0, 0, 0);
  od = __builtin_amdgcn_mfma_f32_32x32x16_bf16(pa2, PK(l2, h2), od, 0, 0, 0);
  od = __builtin_amdgcn_mfma_f32_32x32x16_bf16(pa3, PK(l3, h3), od, 0, 0, 0);
#undef PK
}
__device__ __forceinline__ void pv_d0(f32x16* o, int vb, bf16x8 pa0, bf16x8 pa1, bf16x8 pa2, bf16x8 pa3) {
  pv_one<0>(o[0], vb, pa0, pa1, pa2, pa3); pv_one<1>(o[1], vb, pa0, pa1, pa2, pa3); pv_one<2>(o[2], vb, pa0, pa1, pa2, pa3); pv_one<3>(o[3], vb, pa0, pa1, pa2, pa3);
}
struct F8 { f32x4 lo, hi; };
template <bool F32SRC>
__device__ __forceinline__ void attn_unit(const bf16* Qw, const bf16* __restrict__ Kh, const bf16* __restrict__ Vh, const float* __restrict__ Kf, const float* __restrict__ Vf, bf16* Ow, const LAS unsigned long long* mrow, int NT, bool active, LAS unsigned char* lds) {
  const int tid = threadIdx.x, wid = tid >> 6, lane = tid & 63, r32 = lane & 31, hi = lane >> 5;
  LAS unsigned char* V_lds = lds; LAS unsigned char* K_lds = lds + 2 * SHM_V;
  LAS float* ws = (LAS float*)(lds + OFF_WS) + wid * 64; LAS float* li_l = ws; LAS float* al_l = ws + 32;
  float m_reg = -1e30f, l_reg = 0; f32x16 o[4]; bf16x8 qr[8];
#pragma unroll
  for (int d = 0; d < 4; ++d)
#pragma unroll
    for (int r = 0; r < 16; ++r) o[d][r] = 0.f;
#pragma unroll
  for (int d0 = 0; d0 < 8; ++d0) qr[d0] = *reinterpret_cast<const bf16x8*>(Qw + d0 * 16);
  const int sr = tid >> 4, sc = (tid & 15) * 8, vst0 = v_st(sr, sc), vst1 = v_st(32 + sr, sc);
  const int vb0 = (int)(uintptr_t)V_lds + v_rd_base(lane);
  bf16x8 vsA0, vsA1, ksA0, ksA1, vsB0, vsB1, ksB0, ksB1;
  F8 vfA0, vfA1, kfA0, kfA1;
#define F8LD(p) (F8){*(const f32x4*)(p), *(const f32x4*)((p) + 4)}
#define F8BF(p) ({ const v4u w_ = *(const v4u*)(p); (F8){(f32x4){bf_lo(w_.x), bf_hi(w_.x), bf_lo(w_.y), bf_hi(w_.y)}, (f32x4){bf_lo(w_.z), bf_hi(w_.z), bf_lo(w_.w), bf_hi(w_.w)}}; })
#define SLOADF(S, k0) do { const long r0_ = (long)((k0) + sr) * LDK + sc, r1_ = (long)((k0) + 32 + sr) * LDK + sc; \
    if ((k0) < 2048) { vf##S##0 = F8LD(Vf + r0_); vf##S##1 = F8LD(Vf + r1_); kf##S##0 = F8LD(Kf + r0_); kf##S##1 = F8LD(Kf + r1_); } \
    else { vf##S##0 = F8BF(Vh + r0_); vf##S##1 = F8BF(Vh + r1_); kf##S##0 = F8BF(Kh + r0_); kf##S##1 = F8BF(Kh + r1_); } } while (0)
#define SWRITEF(b, S) do { *(LAS v4u*)(V_lds + (b) * SHM_V + vst0) = pack8((vf##S##0).lo, (vf##S##0).hi); *(LAS v4u*)(V_lds + (b) * SHM_V + vst1) = pack8((vf##S##1).lo, (vf##S##1).hi); const int kc = sc * 2; \
    *(LAS v4u*)(K_lds + (b) * SHM_K + KSWZ(sr, kc)) = pack8((kf##S##0).lo, (kf##S##0).hi); *(LAS v4u*)(K_lds + (b) * SHM_K + KSWZ(32 + sr, kc)) = pack8((kf##S##1).lo, (kf##S##1).hi); } while (0)
#define SLOAD(S, k0) do { vs##S##0 = *reinterpret_cast<const bf16x8*>(&Vh[(long)((k0) + sr) * LDK + sc]); vs##S##1 = *reinterpret_cast<const bf16x8*>(&Vh[(long)((k0) + 32 + sr) * LDK + sc]); \
    ks##S##0 = *reinterpret_cast<const bf16x8*>(&Kh[(long)((k0) + sr) * LDK + sc]); ks##S##1 = *reinterpret_cast<const bf16x8*>(&Kh[(long)((k0) + 32 + sr) * LDK + sc]); } while (0)
#define SWRITE(b, S) do { *(LAS bf16x8*)(V_lds + (b) * SHM_V + vst0) = vs##S##0; *(LAS bf16x8*)(V_lds + (b) * SHM_V + vst1) = vs##S##1; const int kc = sc * 2; \
    *(LAS bf16x8*)(K_lds + (b) * SHM_K + KSWZ(sr, kc)) = ks##S##0; *(LAS bf16x8*)(K_lds + (b) * SHM_K + KSWZ(32 + sr, kc)) = ks##S##1; } while (0)
#define SWAIT() asm volatile("s_waitcnt vmcnt(4)" ::: "memory")
#define RESC(a) do { if (__any((a) < 1.f)) { if (hi == 0) al_l[r32] = (a); asm volatile("s_waitcnt lgkmcnt(0)" ::: "memory"); \
    _Pragma("unroll") for (int d = 0; d < 4; ++d) _Pragma("unroll") for (int r = 0; r < 16; ++r) o[d][r] *= al_l[crow(r, hi)]; } } while (0)
  f32x16 p0, p1; float mn, al = 1.f; bf16x8 pa0, pa1, pa2, pa3;
#define TILE(buf, tt) do { if (active) { qkt(p0, p1, K_lds + (buf) * SHM_K, qr, r32, hi, mrow[tt]); partialSM(p0, p1, m_reg, mn, al); RESC(al); \
    finishSM(p0, p1, al, l_reg, pa0, pa1, pa2, pa3); SBAR(); pv_d0(o, vb0 + (buf) * (int)SHM_V, pa0, pa1, pa2, pa3); } } while (0)
  if constexpr (F32SRC) {
    SLOADF(A, 0);
    for (int j = 0; j < NT; ++j) { const int buf = j & 1;
      SWRITEF(buf, A); __syncthreads();
      if (j + 1 < NT) SLOADF(A, (j + 1) * KVBLK);
      TILE(buf, j);
    }
  } else {
    SLOAD(A, 0); SLOAD(B, KVBLK);
    for (int j = 0; j < NT; j += 2) {
      SWRITE(0, A); __syncthreads();
      if (j + 2 < NT) SLOAD(A, (j + 2) * KVBLK);
      TILE(0, j);
      SWRITE(1, B); __syncthreads();
      if (j + 3 < NT) SLOAD(B, (j + 3) * KVBLK);
      TILE(1, j + 1);
    }
  }
  if (active) {
    if (hi == 0) li_l[r32] = l_reg; asm volatile("s_waitcnt lgkmcnt(0)" ::: "memory");
    float rli[16];
#pragma unroll
    for (int r = 0; r < 16; ++r) rli[r] = __builtin_amdgcn_rcpf(li_l[crow(r, hi)]);
#pragma unroll
    for (int r = 0; r < 16; ++r) { const int orow = crow(r, hi);
#pragma unroll
      for (int d0 = 0; d0 < 4; ++d0) Ow[(long)orow * QW + d0 * 32 + r32] = f2bf1(o[d0][r] * rli[r]); }
  }
#undef TILE
#undef SLOAD
#undef SWRITE
#undef SLOADF
#undef SWRITEF
#undef F8LD
#undef F8BF
#undef SWAIT
#undef RESC
}
#undef KSWZ
}

__device__ __forceinline__ void attn_item(Frame& F, int it, bool dry = false) {
    bool samp; int b, c, n;
    if (it < 512) { samp = false; c = 31 - (it >> 5); b = (it >> 2) & 7; n = it & 3; }
    else if (it < 640) { samp = true; c = 32; b = (it - 512) >> 2; n = it & 3; }
    else { samp = false; c = 15 - ((it - 640) >> 5); b = ((it - 640) >> 2) & 7; n = it & 3; }
    const int R0 = samp ? MP + 32 * b : 2048 * b + 64 * c;
    const int NT = samp ? 34 : ((c + 2) & ~1);
    const int nq = samp ? 32 : 64;
    { const v4u* src = (const v4u*)(WSP(unsigned long long, WS_MASK) + (size_t)R0 * MTILES); LAS v4u* dst = (LAS v4u*)(F.lds + att::OFF_MK);
      for (int i = F.tid; i < nq * MTILES / 2; i += NTHREADS) dst[i] = src[i]; }
    const int g = F.wave & 3, qhalf = samp ? 0 : (F.wave >> 2), r32 = F.lane & 31, hi = F.lane >> 5;
    const bool active = samp ? (F.wave < 4) : true;
    const int qloc = 32 * qhalf + r32;
    bf16* Qb = WSP(bf16, WS_Q) + (size_t)(R0 + qloc) * QW + (4 * n + g) * 128;
    const bf16* Kh = samp ? WSP(bf16, WS_KCAT) + (size_t)b * LCAT * KVW + 128 * n : WSP(bf16, WS_KP) + (size_t)b * 2048 * KVW + 128 * n;
    const bf16* Vh = samp ? WSP(bf16, WS_VCAT) + (size_t)b * LCAT * KVW + 128 * n : WSP(bf16, WS_VP) + (size_t)b * 2048 * KVW + 128 * n;
    const LAS unsigned long long* mrow = (const LAS unsigned long long*)(F.lds + att::OFF_MK) + qloc * MTILES;
    bf16* Ow = (dry ? WSP(bf16, WS_H) : WSP(bf16, WS_Q)) + (size_t)(R0 + 32 * qhalf) * QW + (4 * n + g) * 128;
    if (samp) { const float* Kf = INP(2) + (size_t)b * 2048 * KVW + 128 * n; const float* Vf = INP(3) + (size_t)b * 2048 * KVW + 128 * n;
        att::attn_unit<true>(Qb + hi * 8, Kh, Vh, Kf, Vf, Ow, mrow, NT, active, F.lds); }
    else att::attn_unit<false>(Qb + hi * 8, Kh, Vh, nullptr, nullptr, Ow, mrow, NT, active, F.lds);
}

__device__ __forceinline__ void p6_sample_rows(Frame& F) {
    const int sw = F.wave * F.G + F.vcu, NGW = F.G * NWAVES;
    float* ssq2 = (float*)(F.ctl + CW_SSQ2);
    for (int r = sw; r < MS; r += NGW) {
        const int m = MP + r, p = m & 255;
        const GAS f32x4* xr = (const GAS f32x4*)(INP(1) + (size_t)r * DM) + 2 * F.lane; const GAS f32x4* pr = (const GAS f32x4*)(WSP(float, WS_PART) + (size_t)r * DM) + 2 * F.lane;
        GAS v4u* dst = (GAS v4u*)(WSP(bf16, WS_X1B) + (size_t)((m & ~255) + perm_row(p)) * DM) + F.lane;
        constexpr size_t PL = (size_t)MS * DM / 4;
        float s = 0.f;
#pragma unroll
        for (int j = 0; j < 8; ++j) { const int o = 128 * j;
            const f32x4 v0 = xr[o] + ((pr[o] + pr[o + PL]) + (pr[o + 2 * PL] + pr[o + 3 * PL])), v1 = xr[o + 1] + ((pr[o + 1] + pr[o + 1 + PL]) + (pr[o + 1 + 2 * PL] + pr[o + 1 + 3 * PL]));
            s += (v0[0] * v0[0] + v0[1] * v0[1]) + (v0[2] * v0[2] + v0[3] * v0[3]) + (v1[0] * v1[0] + v1[1] * v1[1]) + (v1[2] * v1[2] + v1[3] * v1[3]);
            dst[64 * j] = pack8(v0, v1); }
        s = wave_sum(s);
        if (F.lane == 0) ssq2[m] = s;
    }
}
__device__ __forceinline__ void p1_finish(Frame& F) {
    const int gt = F.vcu * NTHREADS + F.tid, NGT = F.G * NTHREADS;
    const float* PT = (const float*)F.out; constexpr size_t PL = (size_t)MT * 128;
    const float* tabI = WSP(float, WS_TABI);
    for (int i = gt; i < MT * 9; i += NGT) {
        const int row = i / 9, task = i - row * 9;
        const bool samp = row >= MP; const int r2 = row - MP;
        const float* p = PT + (size_t)row * 128;
        if (task >= 7) { const int c = 64 + 8 * (task - 7);
            const f32x4 a = (*(const f32x4*)(p + c) + *(const f32x4*)(p + PL + c)) + *(const f32x4*)(p + 2 * PL + c), b = (*(const f32x4*)(p + c + 4) + *(const f32x4*)(p + PL + c + 4)) + *(const f32x4*)(p + 2 * PL + c + 4);
            float* wp = WSP(float, WS_WI) + (size_t)row * 16 + 8 * (task - 7); *(f32x4*)wp = a * 0.03125f; *(f32x4*)(wp + 4) = b * 0.03125f; continue; }
        const size_t drow = samp ? (size_t)((r2 >> 5) * LCAT + 2048 + (r2 & 31)) : (size_t)row;
        bf16* kd = (samp ? WSP(bf16, WS_KICAT) : WSP(bf16, WS_KIP)) + drow * IDXD;
        float* od = F.out + (samp ? O_KIS : O_KIP) + (size_t)(samp ? r2 : row) * IDXD;
        if (task == 0) {
            f32x4 v[4];
#pragma unroll
            for (int q = 0; q < 4; ++q) v[q] = (*(const f32x4*)(p + 4 * q) + *(const f32x4*)(p + PL + 4 * q)) + *(const f32x4*)(p + 2 * PL + 4 * q);
            const int pos = samp ? 2048 + (r2 & 31) : (row & 2047);
            const f32x4* tp = (const f32x4*)(tabI + pos * 16); const f32x4 t0 = tp[0], t1 = tp[1], t2 = tp[2], t3 = tp[3];
            const float cs[8] = {t0[0], t0[2], t1[0], t1[2], t2[0], t2[2], t3[0], t3[2]}, sn[8] = {t0[1], t0[3], t1[1], t1[3], t2[1], t2[3], t3[1], t3[3]};
            f32x4 o[4];
#pragma unroll
            for (int j = 0; j < 8; ++j) { const float x1 = v[j >> 2][j & 3], x2 = v[2 + (j >> 2)][j & 3]; o[j >> 2][j & 3] = x1 * cs[j] - x2 * sn[j]; o[2 + (j >> 2)][j & 3] = x2 * cs[j] + x1 * sn[j]; }
            *(v4u*)kd = pack8(o[0], o[1]); *(v4u*)(kd + 8) = pack8(o[2], o[3]);
#pragma unroll
            for (int q = 0; q < 4; ++q) *(f32x4*)(od + 4 * q) = o[q];
        } else { const int c = 8 * (task + 1);
            const f32x4 a = (*(const f32x4*)(p + c) + *(const f32x4*)(p + PL + c)) + *(const f32x4*)(p + 2 * PL + c), b = (*(const f32x4*)(p + c + 4) + *(const f32x4*)(p + PL + c + 4)) + *(const f32x4*)(p + 2 * PL + c + 4);
            *(v4u*)(kd + c) = pack8(a, b); *(f32x4*)(od + c) = a; *(f32x4*)(od + c + 4) = b; }
    }
}
__device__ __forceinline__ void p8_fixup(Frame& F) {
    const int gt = F.vcu * NTHREADS + F.tid, NGT = F.G * NTHREADS;
    const float* ZF = WSP(float, WS_H); const float* ZL = ZF + (size_t)128 * 2 * NUP;
    const float* cw = INP(16); const float* cb = INP(17); bf16* ACT = WSP(bf16, WS_ACT);
    constexpr int C4 = DFF / 4;
    for (int i = gt; i < 128 * C4; i += NGT) {
        const int beta = i / C4, cg = 4 * (i - beta * C4), cu = DFF + cg;
        if ((beta & 15) == 0) continue;
        const float* zl = ZL + (size_t)(beta - 1) * 2 * NUP; const float* zf = ZF + (size_t)beta * 2 * NUP;
        const f32x4 g2 = *(const f32x4*)(zl + cg), g1 = *(const f32x4*)(zl + NUP + cg), ga = *(const f32x4*)(zf + cg), gb = *(const f32x4*)(zf + NUP + cg);
        const f32x4 u2 = *(const f32x4*)(zl + cu), u1 = *(const f32x4*)(zl + NUP + cu), ua = *(const f32x4*)(zf + cu), ub = *(const f32x4*)(zf + NUP + cu);
        const f32x4 w0g = *(const f32x4*)(cw + cg), w1g = *(const f32x4*)(cw + NUP + cg), w2g = *(const f32x4*)(cw + 2 * NUP + cg), bg = *(const f32x4*)(cb + cg);
        const f32x4 w0u = *(const f32x4*)(cw + cu), w1u = *(const f32x4*)(cw + NUP + cu), w2u = *(const f32x4*)(cw + 2 * NUP + cu), bu = *(const f32x4*)(cb + cu);
        const f32x4 cg0 = bg + w0g * g2 + w1g * g1 + w2g * ga, cu0 = bu + w0u * u2 + w1u * u1 + w2u * ua;
        const f32x4 cg1 = bg + w0g * g1 + w1g * ga + w2g * gb, cu1 = bu + w0u * u1 + w1u * ua + w2u * ub;
        f32x4 a0, a1;
#pragma unroll
        for (int k = 0; k < 4; ++k) { a0[k] = cg0[k] * sigmoidf_(cg0[k]) * cu0[k]; a1[k] = cg1[k] * sigmoidf_(cg1[k]) * cu1[k]; }
        v2u w0, w1; w0.x = cvt_pk_bf16(a0[0], a0[1]); w0.y = cvt_pk_bf16(a0[2], a0[3]); w1.x = cvt_pk_bf16(a1[0], a1[1]); w1.y = cvt_pk_bf16(a1[2], a1[3]);
        bf16* ap = ACT + (size_t)(128 * beta) * DFF + cg;
        *(v2u*)ap = w0; *(v2u*)(ap + DFF) = w1;
    }
}
__device__ __forceinline__ void p10_final(Frame& F) {
    const int gw = F.vcu * NWAVES + F.wave, NGW = F.G * NWAVES;
    const GAS f32x4* gr = (const GAS f32x4*)INP(19) + F.lane;
    constexpr size_t PL = (size_t)MS * DM / 4;
    const int sw = F.wave * F.G + F.vcu, np = gw < MP ? (MP - gw + NGW - 1) / NGW : 0, ns = sw < MS ? (MS - sw + NGW - 1) / NGW : 0;
    for (int i = 0; i < np + ns; ++i) { const int m = i < np ? gw + i * NGW : MP + sw + (i - np) * NGW;
        f32x4 v[16];
        if (m < MP) { const GAS v2u* xr = (const GAS v2u*)(WSP(bf16, WS_X2B) + (size_t)m * DM) + F.lane;
#pragma unroll
            for (int j = 0; j < 16; ++j) { const v2u w = xr[64 * j]; v[j] = (f32x4){bf_lo(w.x), bf_hi(w.x), bf_lo(w.y), bf_hi(w.y)}; } }
        else { const int p = m & 255; const GAS v2u* xr = (const GAS v2u*)(WSP(bf16, WS_X1B) + (size_t)((m & ~255) + perm_row(p)) * DM) + F.lane;
            const GAS f32x4* pr = (const GAS f32x4*)(WSP(float, WS_PART) + (size_t)(m - MP) * DM) + F.lane;
#pragma unroll
            for (int j = 0; j < 16; ++j) { const v2u w = xr[64 * j]; const int o = 64 * j;
                v[j] = (f32x4){bf_lo(w.x), bf_hi(w.x), bf_lo(w.y), bf_hi(w.y)} + ((pr[o] + pr[o + PL]) + (pr[o + 2 * PL] + pr[o + 3 * PL])); } }
        float s = 0.f;
#pragma unroll
        for (int j = 0; j < 16; ++j) s += (v[j].x * v[j].x + v[j].y * v[j].y) + (v[j].z * v[j].z + v[j].w * v[j].w);
        const float r = 1.f / sqrtf(wave_sum(s) * (1.f / DM) + EPS);
        GAS f32x4* orow = (GAS f32x4*)(F.out + (size_t)m * DM) + F.lane;
#pragma unroll
        for (int j = 0; j < 16; ++j) orow[64 * j] = v[j] * r * gr[64 * j];
    }
}

#ifndef PHMASK
#define PHMASK 0xFFF
#endif
#define PH(k) ((PHMASK >> (k)) & 1)
__global__ void __launch_bounds__(NTHREADS, 2) fwd_kernel(Args args) {
    extern __shared__ __attribute__((aligned(16))) unsigned char lds[];
    Frame F; F.qpar = 0;
    F.lds = (LAS unsigned char*)lds;
    F.MISC = (volatile LAS unsigned*)(F.lds + MISC_OFF);
    F.tid = threadIdx.x; F.lane = F.tid & 63; F.wave = __builtin_amdgcn_readfirstlane(F.tid >> 6);
    F.G = gridDim.x; { const int bx = blockIdx.x; F.vcu = (F.G % 8 == 0) ? (bx % 8) * (F.G / 8) + bx / 8 : bx; }
    F.ka = (KA*)__builtin_amdgcn_kernarg_segment_ptr();
    F.out = args.out; F.ws = args.ws;
    F.ctl = (gu32*)(F.ws + WS_CTL);
    for (int u = F.tid; u < (LDS_BYTES - LDSCTL_OFF) / 4; u += NTHREADS) ((LAS unsigned*)(F.lds + LDSCTL_OFF))[u] = 0u;
    __syncthreads();
    XcdBarrier bar = xcd_barrier_post((unsigned*)(F.ctl + CW_BAR), F.MISC + 8);
#define GRID_BAR() xcd_barrier(bar)
    LAS unsigned char* ring = F.lds;

#if PH(0)
    p0_prologue(F);
#if defined(PROBE_P0)
    p0_prologue(F);
#endif
    GRID_BAR();
#endif
#if PH(1)
    { pg8::Gemm g{WSP(bf16, WS_H), WSP(bf16, WS_W1T), MT, N1, DM, DM}; ProjOrder S; S.init(MT, N1 - 256, F.G, (int)blockIdx.x);
      EpiProj E{F.ws, F.out};
      pg8::gemm_phase<EpiProj, ProjOrder, true, true>(ring, g, S, E);
      for (;;) { const int c = q_next(F, CW_DQ3); if (c >= 204 + 64 + 64 + 128) break;
        if (c < 204) { const int sl = c / 68, koff = sl * 1408;
          pg8::Gemm g2{WSP(bf16, WS_H) + koff, WSP(bf16, WS_W1T) + koff, MT, N1, sl < 2 ? 1408 : 1280, DM}; ThinOrder T{c};
          EpiThinPart EP{F.out + (size_t)sl * MT * 128};
          pg8::gemm_phase<EpiThinPart, ThinOrder, true, true>(ring, g2, T, EP); }
        else if (c < 268) transpose_range(F, INP(11), DA, DM, WSP(bf16, WS_WAT), RowId(), nullptr, 64 * (c - 204) + F.wave, NWAVES, 64 * (c - 204) + 64);
        else if (c < 332) transpose_range(F, INP(12), QW, DM, WSP(bf16, WS_WBT), RowId(), nullptr, 64 * (c - 268) + F.wave, NWAVES, 64 * (c - 268) + 64);
        else transpose_range(F, INP(13), DM, DM, WSP(bf16, WS_WOT), RowId(), nullptr, 64 * (c - 332) + F.wave, NWAVES, 64 * (c - 332) + 64); } }
    GRID_BAR();
    p1_finish(F);
    GRID_BAR();
#endif
#if PH(2)
    for (;;) { const int it = q_next(F, CW_Q2); if (it >= 512) break;
#if defined(PROBE_MIX) || defined(PROBE_IDX)
        idx_item(F, it); __syncthreads();
#endif
        idx_item(F, it); }
    for (;;) { const int i4 = q_next(F, CW_Q2B); if (i4 >= 512) break;
        const int first = i4 < 256 ? 4 * i4 : 768 + i4, cnt = i4 < 256 ? 4 : 1;
#pragma unroll 1
        for (int k = 0; k < cnt; ++k) { gmlp_item(F, first + k); __syncthreads(); } }
    GRID_BAR();
#endif
#if PH(3)
    for (;;) { const int it = q_next(F, CW_Q3); if (it >= 1152) break;
#if defined(PROBE_MIX) || defined(PROBE_ATT)
        attn_item(F, it, true); __syncthreads();
#endif
        attn_item(F, it); }
    GRID_BAR();
#endif
#if PH(4)
    { pg8::Gemm g{WSP(bf16, WS_U), WSP(bf16, WS_WAT), MT, DM, DA, DA}; pg8::StaticOrder S; S.init(MT, DM, F.G, (int)blockIdx.x);
      EpiMergeA E{F.ws, (bf16*)F.out};
      pg8::gemm_phase<EpiMergeA, pg8::StaticOrder, true, true>(ring, g, S, E); }
#endif
#if PH(5)
    { pg8::Gemm g{WSP(bf16, WS_Q), WSP(bf16, WS_WBT), MT, DM, QW, QW}; pg8::StaticOrder S; S.init(MT, DM, F.G, (int)blockIdx.x);
      EpiMergeB E{F.ws, (const bf16*)F.out};
      pg8::gemm_phase<EpiMergeB, pg8::StaticOrder, true, true>(ring, g, S, E); }
    for (;;) { const int b = q_next(F, CW_DQ4); if (b >= 64 * 688 / 64) break;
        transpose_range(F, INP(15), DM, NUP, WSP(bf16, WS_WUPT), RowWup(), INP(14), 64 * b + F.wave, NWAVES, 64 * b + 64); }
    GRID_BAR();
#endif
#if PH(6)
    { pg8::Gemm g{WSP(bf16, WS_H), WSP(bf16, WS_WOT), MP, DM, DM, DM}; pg8::StaticOrder S; S.init(MP, DM, F.G, (int)blockIdx.x);
      EpiX1 E{F.ws, F.ka};
      pg8::gemm_phase<EpiX1, pg8::StaticOrder, true, true>(ring, g, S, E);
      if (F.G == 256) { const int sl = (int)blockIdx.x >> 6;
        pg8::Gemm g2{WSP(bf16, WS_H) + sl * 1024, WSP(bf16, WS_WOT) + sl * 1024, MT, DM, 1024, DM}; RemOrder R{(int)blockIdx.x};
        EpiPart EP{WSP(float, WS_PART) + (size_t)sl * MS * DM};
        pg8::gemm_phase<EpiPart, RemOrder, true, true>(ring, g2, R, EP); }
      for (;;) { const int b = q_next(F, CW_DQ5); if (b >= 100) break; transpose_range(F, INP(18), DFF, DM, WSP(bf16, WS_WDNT), RowId(), nullptr, 64 * b + F.wave, NWAVES, 64 * b + 64); } }
    GRID_BAR();
#endif
#if PH(7)
    p6_sample_rows(F);
    GRID_BAR();
#endif
#if PH(8)
    { pg8::Gemm g{WSP(bf16, WS_U), WSP(bf16, WS_WUPT), MT, NUP, DM, DM}; UpOrder S; S.init(MT, NUP, F.G, (int)blockIdx.x); S.ws = F.ws; S.ka = F.ka; S.par = F.lds + RING_BYTES; S.k = 0; S.initd(F.ctl, F.MISC + 32);
      EpiUp E{F.ws, F.out, F.ka, F.lds + RING_BYTES, 0};
      pg8::gemm_phase<EpiUp, UpOrder, true, true>(ring, g, S, E);
      if (S.dyn) {
        for (;;) { const int b = q_next(F, CW_DQ2); if (b >= 244) break; transpose_range(F, INP(18), DFF, DM, WSP(bf16, WS_WDNT), RowId(), nullptr, 6400 + 64 * b + F.wave, NWAVES, 6400 + 64 * b + 64); } }
      else { const int extra = (68 * 86) % F.G, c = (int)blockIdx.x;
        if (extra == 0) transpose_matrix(F, INP(18), DFF, DM, WSP(bf16, WS_WDNT), RowId(), nullptr, -1, 0, 50, 172);
        else if (c >= extra) transpose_matrix(F, INP(18), DFF, DM, WSP(bf16, WS_WDNT), RowId(), nullptr, c - extra, F.G - extra, 50, 172); }
#if defined(PROBE_P7)
      pg8::gemm_phase<EpiUp, UpOrder, true, true>(ring, g, S, E);
#endif
#if defined(PROBE_P7N)
      { EpiNull EN; pg8::gemm_phase<EpiNull, UpOrder, true, true>(ring, g, S, EN); }
#endif
    }
    GRID_BAR();
#endif
#if PH(9)
    p8_fixup(F);
    GRID_BAR();
#endif
#if PH(10)
    { pg8::Gemm g{WSP(bf16, WS_ACT), WSP(bf16, WS_WDNT), MP, DM, DFF, DFF}; pg8::StaticOrder S; S.init(MP, DM, F.G, (int)blockIdx.x);
      EpiX2 E{F.ws};
#if defined(PROBE_P9N)
      { EpiNull EN; pg8::gemm_phase<EpiNull, pg8::StaticOrder, true, true>(ring, g, S, EN); }
#endif
      pg8::gemm_phase<EpiX2, pg8::StaticOrder, true, true>(ring, g, S, E);
      if (F.G == 256) {
        const int c = (int)blockIdx.x, sl = c >> 6, t = ((c & 63) + 2 * sl) & 63;
        int slow; { const unsigned v = F.lane < 8 ? __hip_atomic_load(F.ctl + CW_CL + 256 * F.lane + 22, RLX_AGENT) : 0u;
          unsigned key = (v >> 16) == 22u ? ((v & 0xffffu) << 3) | (unsigned)F.lane : 0u;
          key = max(key, (unsigned)__shfl_xor((int)key, 1)); key = max(key, (unsigned)__shfl_xor((int)key, 2)); key = max(key, (unsigned)__shfl_xor((int)key, 4));
          slow = (key >> 3) > 183u ? (int)(key & 7u) : -1; }
        slow = __builtin_amdgcn_readfirstlane(slow);
        const int sls = (slow >= 0 && ((t ^ slow) & 1) == 0) ? (((t - slow) >> 1) & 3) : -1;
        const int kt0 = sls < 0 ? (sl < 2 ? 44 * sl : 88 + 42 * (sl - 2)) : 48 * sl - (sl > sls ? 20 : 0), ktn = sls < 0 ? (sl < 2 ? 44 : 42) : (sl == sls ? 28 : 48);
        const int koff = 64 * kt0, klen = 64 * ktn;
        pg8::Gemm g2{WSP(bf16, WS_ACT) + koff, WSP(bf16, WS_WDNT) + koff, MT, DM, klen, DFF}; RemOrder R{t};
        EpiPart EP{WSP(float, WS_PART) + (size_t)sl * MS * DM};
        pg8::gemm_phase<EpiPart, RemOrder, true, true>(ring, g2, R, EP); } }
    GRID_BAR();
#endif
#if PH(11)
    p10_final(F);
#endif
}

extern "C" void kernel_launch(void* const* d_in, const int* in_sizes, int n_in, void* d_out, int out_size, void* d_ws, size_t ws_size, hipStream_t stream) {
    static int grid = 0;
    if (grid == 0) {
        if (n_in != 20 || out_size != (int)O_END || ws_size < WS_END) { fprintf(stderr, "kernel_launch: unexpected shapes: n_in %d out %d ws %zu (need %zu)\n", n_in, out_size, ws_size, (size_t)WS_END); grid = -1; return; }
        int dev = 0, cus = 0, per_cu = 0;
        if (hipGetDevice(&dev) != hipSuccess || hipDeviceGetAttribute(&cus, hipDeviceAttributeMultiprocessorCount, dev) != hipSuccess) { grid = -1; return; }
        if (hipFuncSetAttribute((const void*)fwd_kernel, hipFuncAttributeMaxDynamicSharedMemorySize, LDS_BYTES) != hipSuccess) { fprintf(stderr, "kernel_launch: hipFuncSetAttribute failed\n"); grid = -1; return; }
        if (hipOccupancyMaxActiveBlocksPerMultiprocessor(&per_cu, (const void*)fwd_kernel, NTHREADS, LDS_BYTES) != hipSuccess || per_cu < 1)
            fprintf(stderr, "kernel_launch: note: occupancy query reports %d workgroups per CU\n", per_cu);
        (void)hipGetLastError();
        grid = cus;
    }
    if (grid < 0) return;
    if (hipMemsetAsync((char*)d_ws + WS_CTL, 0, CTL_ZERO_BYTES, stream) != hipSuccess) return;
    Args a{};
    for (int i = 0; i < 20; ++i) a.in[i] = (const float*)d_in[i];
    a.out = (float*)d_out; a.ws = (unsigned char*)d_ws;
    hipLaunchKernelGGL(fwd_kernel, dim3(grid), dim3(NTHREADS), LDS_BYTES, stream, a);
    const hipError_t le = hipPeekAtLastError();
    if (le != hipSuccess) fprintf(stderr, "kernel_launch: launch failed: %s\n", hipGetErrorName(le));
}
```

```cpp
#include <hip/hip_runtime.h>
#include <cstdio>
#include <cstdint>
namespace pg8 {
#define PG8_LAS __attribute__((address_space(3)))
typedef unsigned short bf16_t;
typedef short bf16x8 __attribute__((ext_vector_type(8)));
typedef float f32x4 __attribute__((ext_vector_type(4)));
typedef unsigned u32x4 __attribute__((ext_vector_type(4)));
constexpr int BM = 256, BK = 64, HALF = 128, HTB = HALF * BK * 2  , STAGE_BYTES = 8 * HTB, NXCD = 8, WGM = 8;

__host__ __device__ __forceinline__ int lds_byte(int r, int c) { const int st = (r >> 4) * 2 + (c >> 5), rr = r & 15, cc = c & 31, ob = rr * 64 + cc * 2; return st * 1024 + (ob ^ (((ob >> 9) & 1) << 5)); }
__host__ __device__ __forceinline__ void stage_rc(int b, int& R, int& C) { const int st = b / 1024, sb = b % 1024, swz = sb ^ (((sb >> 9) & 1) << 5); R = (st >> 1) * 16 + swz / 64; C = (st & 1) * 32 + (swz % 64) / 2; }
__host__ __device__ __forceinline__ int perm32(int rho) { const int n = rho >> 4, i = rho & 15; return 8 * (i >> 2) + 4 * n + (i & 3); }

struct Unit { int pm, pn; };
struct Gemm { const bf16_t* A; const bf16_t* Bt; int M, N, K, ld; };

struct StaticOrder {
    int nM, nN, nwg, G, c;
    __host__ __device__ void init(int M, int N, int G_, int c_) { nM = M / BM; nN = N / BM; nwg = nM * nN; G = G_; c = c_; }
    __host__ __device__ bool next(int i, Unit& u) const {
        const long L = (long)i * G + c; if (L >= nwg) return false;
        int wgid = (int)L; { const int q = nwg / NXCD, r = nwg % NXCD, xcd = wgid % NXCD, off = wgid / NXCD; wgid = (xcd < r ? xcd * (q + 1) : r * (q + 1) + (xcd - r) * q) + off; }
        const int nig = WGM * nN, gid = wgid / nig, fm = gid * WGM, gsz = (nM - fm) < WGM ? (nM - fm) : WGM;
        u.pm = fm + ((wgid % nig) % gsz); u.pn = (wgid % nig) / gsz; return true;
    }
    __device__ __forceinline__ void a_ready(const Unit&) const {}
    __device__ __forceinline__ void done(const Unit&) const {}
};
__device__ __forceinline__ unsigned cvt_pk_bf16(float lo, float hi) { unsigned r; asm volatile("v_cvt_pk_bf16_f32 %0, %1, %2" : "=v"(r) : "v"(lo), "v"(hi)); return r; }
template <class Epi, class Sched, bool ALIGN_EPI = false, bool SP2 = false>
__device__ __forceinline__ void gemm_phase(PG8_LAS unsigned char* lds, const Gemm g, const Sched& S, const Epi& E) {
    int tid_ = threadIdx.x; asm volatile("" : "+v"(tid_));
    const int tid = tid_, wid = __builtin_amdgcn_readfirstlane(tid >> 6), lane = tid & 63, wr = wid >> 2, wc = wid & 3, fr = lane & 15, fq = lane >> 4;
    const int K = g.K, nt = K / BK;
    unsigned voffA[2], voffB[2];
#pragma unroll
    for (int i = 0; i < 2; ++i) { int R, C; stage_rc(tid * 16 + i * 8192, R, C); const int Rb = Epi::PERM ? ((R & ~31) + perm32(R & 31)) : R;
        voffA[i] = (unsigned)(R * g.ld + C) * 2u; voffB[i] = (unsigned)(Rb * g.ld + C) * 2u; }
    const size_t kstep = (size_t)(BK * 2);
    const size_t hstep = (size_t)HALF * g.ld * 2;
    const size_t tstep = 2 * hstep;
    const unsigned ldsw = (unsigned)wid * 1024u;
    const int aoff = lds_byte(wr * 64 + fr, fq * 8), boff = lds_byte(wc * 32 + fr, fq * 8);
#define PG8_SA(b, h) (((b) * 2 + (h)) * HTB)
#define PG8_SB(b, h) ((4 + (b) * 2 + (h)) * HTB)
#define PG8_STAGE(bufoff, gbase, voff) do { _Pragma("unroll") for (int _i = 0; _i < 2; ++_i) \
        __builtin_amdgcn_global_load_lds((const unsigned*)((const char*)(gbase) + (voff)[_i]), (PG8_LAS unsigned*)(lds + (bufoff) + ldsw + _i * 8192), 16, 0, 0); } while (0)
#define PG8_LDA(dst, b, h) do { _Pragma("unroll") for (int m = 0; m < 4; ++m) _Pragma("unroll") for (int k = 0; k < 2; ++k) dst[m][k] = *(const PG8_LAS bf16x8*)(lds + PG8_SA(b, h) + aoff + m * 2048 + k * 1024); } while (0)
#define PG8_LDB(dst, b, h) do { _Pragma("unroll") for (int n = 0; n < 2; ++n) _Pragma("unroll") for (int k = 0; k < 2; ++k) dst[n][k] = *(const PG8_LAS bf16x8*)(lds + PG8_SB(b, h) + boff + n * 2048 + k * 1024); } while (0)
#define PG8_MMA(ai, bj, At, Bt) do { __builtin_amdgcn_s_setprio(1); _Pragma("unroll") for (int m = 0; m < 4; ++m) _Pragma("unroll") for (int n = 0; n < 2; ++n) _Pragma("unroll") for (int k = 0; k < 2; ++k) \
        acc[ai][bj][m][n] = __builtin_amdgcn_mfma_f32_16x16x32_bf16(Bt[n][k], At[m][k], acc[ai][bj][m][n], 0, 0, 0); __builtin_amdgcn_s_setprio(0); } while (0)
#define PG8_WAIT_V(n) asm volatile("s_waitcnt vmcnt(" #n ")" ::: "memory")
#define PG8_WAIT_L(n) asm volatile("s_waitcnt lgkmcnt(" #n ")" ::: "memory")
#define PG8_BAR __builtin_amdgcn_s_barrier()
#define PG8_SCHED __builtin_amdgcn_sched_barrier(0)
    Unit cur, nxt; int ui = 0;
    if (!S.next(0, cur)) return;
    f32x4 acc[2][2][4][2];
#pragma unroll
    for (int a = 0; a < 2; ++a)
#pragma unroll
        for (int b = 0; b < 2; ++b)
#pragma unroll
            for (int m = 0; m < 4; ++m)
#pragma unroll
                for (int n = 0; n < 2; ++n) acc[a][b][m][n] = (f32x4){0.f, 0.f, 0.f, 0.f};
    bf16x8 At[4][2], B0[2][2], B1[2][2];
    const char* cA = (const char*)g.A + (size_t)cur.pm * tstep; const char* cB = (const char*)g.Bt + (size_t)cur.pn * tstep;
    S.a_ready(cur);
    if constexpr (SP2) {
        PG8_STAGE(PG8_SB(0, 0), cB, voffB); PG8_STAGE(PG8_SB(0, 1), cB + hstep, voffB); PG8_STAGE(PG8_SA(0, 0), cA, voffA); PG8_STAGE(PG8_SA(0, 1), cA + hstep, voffA);
        if (wr == 1) PG8_BAR;
        PG8_WAIT_V(2); PG8_BAR;
        PG8_STAGE(PG8_SB(1, 0), cB + kstep, voffB); PG8_STAGE(PG8_SA(1, 0), cA + kstep, voffA); PG8_STAGE(PG8_SB(1, 1), cB + hstep + kstep, voffB);
        PG8_WAIT_V(6); PG8_BAR;
    } else {
        PG8_STAGE(PG8_SB(0, 0), cB, voffB); PG8_STAGE(PG8_SA(0, 0), cA, voffA); PG8_STAGE(PG8_SB(0, 1), cB + hstep, voffB); PG8_STAGE(PG8_SA(0, 1), cA + hstep, voffA);
        if (wr == 1) PG8_BAR;
        PG8_WAIT_V(4); PG8_BAR;
        PG8_STAGE(PG8_SB(1, 0), cB + kstep, voffB); PG8_STAGE(PG8_SA(1, 0), cA + kstep, voffA); PG8_STAGE(PG8_SB(1, 1), cB + hstep + kstep, voffB);
        PG8_WAIT_V(6); PG8_BAR;
    }
    for (;;) {
        const bool has_next = S.next(ui + 1, nxt);
        const char* nA = has_next ? (const char*)g.A + (size_t)nxt.pm * tstep : cA; const char* nB = has_next ? (const char*)g.Bt + (size_t)nxt.pn * tstep : cB;
        for (int t = 0; t < nt; t += 2) {
            const bool last = (t == nt - 2);
            const char* a1 = cA + (size_t)(t + 1) * kstep;
            const char* a2 = last ? nA : cA + (size_t)(t + 2) * kstep; const char* b2 = last ? nB : cB + (size_t)(t + 2) * kstep;
            const char* a3 = a2 + kstep; const char* b3 = b2 + kstep;
            if (last && has_next) S.a_ready(nxt);
            if constexpr (SP2) {
            PG8_LDB(B0, 0, 0); PG8_LDB(B1, 0, 1); PG8_SCHED; PG8_LDA(At, 0, 0); PG8_STAGE(PG8_SA(1, 1), a1 + hstep, voffA);
            PG8_WAIT_V(8); PG8_WAIT_L(0); PG8_BAR; PG8_MMA(0, 0, At, B0); PG8_MMA(0, 1, At, B1); PG8_BAR; PG8_SCHED;
            PG8_LDA(At, 0, 1); PG8_STAGE(PG8_SB(0, 0), b2, voffB); PG8_STAGE(PG8_SB(0, 1), b2 + hstep, voffB); PG8_STAGE(PG8_SA(0, 0), a2, voffA);
            PG8_WAIT_V(8); PG8_WAIT_L(0); PG8_BAR; PG8_MMA(1, 0, At, B0); PG8_MMA(1, 1, At, B1); PG8_BAR; PG8_SCHED;
            PG8_LDB(B0, 1, 0); PG8_LDB(B1, 1, 1); PG8_SCHED; PG8_LDA(At, 1, 0); PG8_STAGE(PG8_SA(0, 1), a2 + hstep, voffA);
            PG8_WAIT_V(8); PG8_WAIT_L(0); PG8_BAR; PG8_MMA(0, 0, At, B0); PG8_MMA(0, 1, At, B1); PG8_BAR; PG8_SCHED;
            PG8_LDA(At, 1, 1); PG8_STAGE(PG8_SB(1, 0), b3, voffB); PG8_STAGE(PG8_SB(1, 1), b3 + hstep, voffB); PG8_STAGE(PG8_SA(1, 0), a3, voffA);
            PG8_WAIT_V(8); PG8_WAIT_L(0); PG8_BAR; PG8_MMA(1, 0, At, B0); PG8_MMA(1, 1, At, B1); PG8_BAR; PG8_SCHED;
            } else {
            PG8_LDB(B0, 0, 0); PG8_SCHED; PG8_LDA(At, 0, 0); PG8_STAGE(PG8_SA(1, 1), a1 + hstep, voffA);
            PG8_WAIT_L(8); PG8_BAR; PG8_WAIT_L(0); PG8_MMA(0, 0, At, B0); PG8_BAR; PG8_SCHED;
            PG8_LDB(B1, 0, 1); PG8_STAGE(PG8_SB(0, 0), b2, voffB);
            PG8_BAR; PG8_WAIT_L(0); PG8_MMA(0, 1, At, B1); PG8_BAR;
            PG8_LDA(At, 0, 1); PG8_STAGE(PG8_SA(0, 0), a2, voffA);
            PG8_BAR; PG8_WAIT_L(0); PG8_MMA(1, 0, At, B0); PG8_BAR; PG8_SCHED;
            PG8_STAGE(PG8_SB(0, 1), b2 + hstep, voffB);
            PG8_WAIT_V(6); PG8_BAR; PG8_MMA(1, 1, At, B1); PG8_BAR;
            PG8_LDB(B0, 1, 0); PG8_SCHED; PG8_LDA(At, 1, 0); PG8_STAGE(PG8_SA(0, 1), a2 + hstep, voffA);
            PG8_WAIT_L(8); PG8_BAR; PG8_WAIT_L(0); PG8_MMA(0, 0, At, B0); PG8_BAR; PG8_SCHED;
            PG8_LDB(B1, 1, 1); PG8_STAGE(PG8_SB(1, 0), b3, voffB);
            PG8_BAR; PG8_WAIT_L(0); PG8_MMA(0, 1, At, B1); PG8_BAR;
            PG8_LDA(At, 1, 1); PG8_STAGE(PG8_SA(1, 0), a3, voffA);
            PG8_BAR; PG8_WAIT_L(0); PG8_MMA(1, 0, At, B0); PG8_BAR; PG8_SCHED;
            PG8_STAGE(PG8_SB(1, 1), b3 + hstep, voffB);
            PG8_WAIT_V(6); PG8_BAR; PG8_MMA(1, 1, At, B1); PG8_BAR;
            }
        }
        if constexpr (ALIGN_EPI) { if (wr == 0) PG8_BAR; }
        if constexpr (!Epi::AFTER_DRAIN) { E(acc, cur, wr, wc, fr, fq); S.done(cur); }
        if (!has_next) break;
#pragma unroll
        for (int a = 0; a < 2; ++a)
#pragma unroll
            for (int b = 0; b < 2; ++b)
#pragma unroll
                for (int m = 0; m < 4; ++m)
#pragma unroll
                    for (int n = 0; n < 2; ++n) acc[a][b][m][n] = (f32x4){0.f, 0.f, 0.f, 0.f};
        cur = nxt; cA = nA; cB = nB; ++ui;
        if constexpr (ALIGN_EPI) { if (wr == 1) PG8_BAR; }
    }
    PG8_WAIT_V(0);
    if constexpr (!ALIGN_EPI) { if (wr == 0) PG8_BAR; }
    PG8_BAR;
    if constexpr (Epi::AFTER_DRAIN) { E.fused(acc, cur, wr, wc, fr, fq, lds, wid, lane); S.done(cur); }
#undef PG8_SA
#undef PG8_SB
#undef PG8_STAGE
#undef PG8_LDA
#undef PG8_LDB
#undef PG8_MMA
#undef PG8_WAIT_V
#undef PG8_WAIT_L
#undef PG8_BAR
#undef PG8_SCHED
}
}

constexpr int NWAVES = 8, NTHREADS = 512;
constexpr int DM = 4096;
constexpr int MP = 16384, MS = 1024, MT = MP + MS;
constexpr int DA = 2048, QW = 2048, KVW = 512, IDXW = 1024, IDXD = 64;
constexpr int DFF = 11008, NUP = 22016;
constexpr int INCOLS = 16464, N1 = 16640;
constexpr int LCAT = 2176;
constexpr int MTILES = 34;
constexpr int SCW = 2112;
constexpr float EPS = 1e-6f;
constexpr size_t O_YP = 0, O_YS = 67108864, O_KP = 71303168, O_VP = 79691776, O_KIP = 88080384, O_CP = 89128960,
                 O_KS = 89481216, O_VS = 90005504, O_KIS = 90529792, O_CS = 90595328, O_GV = 92004352, O_END = 94101504;
constexpr size_t MiB = 1u << 20;
constexpr size_t WS_CTL = 0, CTL_ZERO_BYTES = 1 * MiB;
constexpr size_t WS_TABQ = 1 * MiB, WS_TABI = WS_TABQ + 2080 * 16 * 8, WS_WSB = WS_TABI + 2080 * 8 * 8;
static_assert(WS_WSB + 8 * 128 * 128 * 2 <= 2 * MiB, "tables");
constexpr size_t WS_MASK = 2 * MiB;
static_assert(WS_MASK + (size_t)MT * MTILES * 8 <= 8 * MiB, "mask");
constexpr size_t WS_W1T = 8 * MiB, WS_WAT = 138 * MiB, WS_WBT = 154 * MiB, WS_WOT = 170 * MiB, WS_WUPT = 202 * MiB, WS_WDNT = 374 * MiB;
constexpr size_t WS_H = 460 * MiB;
constexpr size_t WS_U = 596 * MiB, WS_V = 664 * MiB;
constexpr size_t WS_Q = 732 * MiB, WS_SA = 800 * MiB, WS_SB = 936 * MiB, WS_QI = 1072 * MiB;
constexpr size_t WS_X1B = WS_U;
constexpr size_t WS_X2B = WS_H;
constexpr size_t WS_ACT = WS_Q;
constexpr size_t WS_KP = 1106 * MiB, WS_VP = 1122 * MiB, WS_KIP = 1138 * MiB;
constexpr size_t WS_KCAT = 1140 * MiB, WS_VCAT = 1208 * MiB, WS_KICAT = 1276 * MiB;
constexpr size_t WS_PART = WS_KCAT;
static_assert((size_t)4 * MS * DM * 4 <= (size_t)32 * LCAT * KVW * 2, "partials fit in the KCAT region");
constexpr size_t WS_WI = 1285 * MiB;
constexpr size_t WS_END = 1287 * MiB;
static_assert(WS_W1T + (size_t)N1 * DM * 2 == WS_WAT && WS_WUPT + (size_t)NUP * DM * 2 == WS_WDNT && WS_WDNT + (size_t)DM * DFF * 2 == WS_H, "weights");
static_assert(WS_H + (size_t)MT * DM * 2 == WS_U && WS_U + (size_t)MT * DA * 2 == WS_V && WS_V + (size_t)MT * DA * 2 == WS_Q, "acts");
static_assert(WS_ACT + (size_t)MT * DFF * 2 <= WS_KP && WS_QI + (size_t)MT * IDXW * 2 == WS_KP, "act overlay");
static_assert(WS_KCAT + (size_t)32 * LCAT * KVW * 2 == WS_VCAT && WS_KICAT + (size_t)32 * LCAT * IDXD * 2 <= WS_WI && WS_WI + (size_t)MT * 16 * 4 <= WS_END, "caches");
static_assert((size_t)256 * 64 * SCW * 4 <= (size_t)MT * DM * 2, "scores scratch fits in the H region");
static_assert((size_t)128 * 2 * 2 * NUP * 4 <= (size_t)MT * DM * 2, "conv edge rows fit in the H region");
constexpr int CW_TMO = 0, CW_Q2 = 64, CW_Q3 = 128, CW_Q2B = 192, CW_DQ = 256, CW_DQ2 = 320, CW_DQ3 = 384, CW_DQ4 = 448, CW_DQ5 = 512, CW_BAR = 4096, CW_CL = 8192  , CW_SSQ = 65536, CW_SSQ2 = 65536 + 32768;
constexpr int RING_BYTES = 131072, LDS_BYTES = 147456,     LDSCTL_OFF = LDS_BYTES - 512, MISC_OFF = LDSCTL_OFF + 320;

#define GAS __attribute__((address_space(1)))
#define LAS __attribute__((address_space(3)))
typedef unsigned short bf16;
typedef unsigned v4u __attribute__((ext_vector_type(4)));
typedef unsigned v2u __attribute__((ext_vector_type(2)));
typedef float f32x4 __attribute__((ext_vector_type(4)));
typedef float f32x16 __attribute__((ext_vector_type(16)));
typedef short bf16x8 __attribute__((ext_vector_type(8)));
typedef short s16x4 __attribute__((ext_vector_type(4)));
typedef GAS unsigned gu32;
#define RLX_AGENT __ATOMIC_RELAXED, __HIP_MEMORY_SCOPE_AGENT
#define LDS_WAIT() asm volatile("s_waitcnt lgkmcnt(0)" ::: "memory")
#define VM_WAIT() asm volatile("s_waitcnt vmcnt(0)" ::: "memory")
using pg8::cvt_pk_bf16;
__device__ __forceinline__ float bf_lo(unsigned w) { return __uint_as_float(w << 16); }
__device__ __forceinline__ float bf_hi(unsigned w) { return __uint_as_float(w & 0xffff0000u); }
__device__ __forceinline__ bf16 f2bf1(float f) { return (bf16)(cvt_pk_bf16(f, 0.f) & 0xffffu); }
__device__ __forceinline__ v4u pack8(f32x4 a, f32x4 b) { v4u w; w.x = cvt_pk_bf16(a[0], a[1]); w.y = cvt_pk_bf16(a[2], a[3]); w.z = cvt_pk_bf16(b[0], b[1]); w.w = cvt_pk_bf16(b[2], b[3]); return w; }
__device__ __forceinline__ float sigmoidf_(float x) { return __builtin_amdgcn_rcpf(1.f + __expf(-x)); }
__device__ __forceinline__ float wave_sum(float v) {
#pragma unroll
    for (int o = 1; o < 64; o <<= 1) v += __shfl_xor(v, o);
    return v;
}
#define XB_TMO      128
#define XB_XCNT(j)  (256  + 64 * (j))
#define XB_XSUB(j)  (1280 + 64 * (j))
#define XB_XGEN(j)  (2304 + 64 * (j))
#define XB_TOP      3328
#define XB_TOPGEN   3392
#define XCD_BAR_WORDS 3456
#define XB_SPIN_CAP (1u << 18)

__device__ __forceinline__ unsigned xb_ld(unsigned* p)              { return __hip_atomic_load(p, __ATOMIC_RELAXED, __HIP_MEMORY_SCOPE_AGENT); }
__device__ __forceinline__ unsigned xb_add(unsigned* p, unsigned v) { return __hip_atomic_fetch_add(p, v, __ATOMIC_RELAXED, __HIP_MEMORY_SCOPE_AGENT); }
__device__ __forceinline__ unsigned xb_xcc_id() { return (unsigned)__builtin_amdgcn_s_getreg((3 << 11) | 20) & 0xFu; }
#define XB_SPIN(cond, bar) do { unsigned _sp = 0; while (cond) { __builtin_amdgcn_s_sleep(1); \
    if ((++_sp & 255u) == 0u) { if (xb_ld(&(bar)[XB_TMO])) break; if (_sp > XB_SPIN_CAP) { atomicAdd(&(bar)[XB_TMO], 1u); break; } } } } while (0)

struct XcdBarrier {
    unsigned* bar; unsigned x;
    volatile LAS unsigned* st;
};

__device__ __forceinline__ XcdBarrier xcd_barrier_post(unsigned* bar, volatile LAS unsigned* st) {
    XcdBarrier b; b.bar = bar; b.x = xb_xcc_id(); b.st = st;
    if (threadIdx.x == 0) (void)xb_add(&bar[XB_XCNT(b.x)], 1u);
    return b;
}
__device__ __forceinline__ void xcd_barrier_complete(unsigned* bar, unsigned x, unsigned& nloc, unsigned& nx) {
    const unsigned G = gridDim.x * gridDim.y * gridDim.z;
    unsigned sum, cnt, mine, sp = 0u;
    for (;;) {
        sum = 0u; cnt = 0u; mine = 0u;
#pragma unroll
        for (unsigned j = 0; j < 16; ++j) { const unsigned c = xb_ld(&bar[XB_XCNT(j)]); sum += c; cnt += (c > 0u) ? 1u : 0u; mine = (j == x) ? c : mine; }
        if (sum == G) break;
        __builtin_amdgcn_s_sleep(1);
        if ((++sp & 255u) == 0u) { if (xb_ld(&bar[XB_TMO])) break; if (sp > XB_SPIN_CAP) { atomicAdd(&bar[XB_TMO], 1u); break; } }
    }
    nloc = mine > 0u ? mine : 1u; nx = cnt > 0u ? cnt : 1u;
}

__device__ __forceinline__ void xcd_barrier(const XcdBarrier& b) {
    asm volatile("s_waitcnt vmcnt(0)" ::: "memory");
    __syncthreads();
    if (threadIdx.x == 0) {
        unsigned* bar = b.bar;
        __builtin_amdgcn_s_waitcnt(0);
        unsigned nloc = b.st[0], nx = b.st[1];
        if (nloc == 0u) { xcd_barrier_complete(bar, b.x, nloc, nx); b.st[0] = nloc; b.st[1] = nx; }
        const unsigned old = xb_add(&bar[XB_XSUB(b.x)], 1u);
        const unsigned gen = old / nloc;
        if (old + 1u == (gen + 1u) * nloc) {
            __builtin_amdgcn_fence(__ATOMIC_RELEASE, "agent");
            asm volatile("s_waitcnt vmcnt(0)" ::: "memory");
            const unsigned og = xb_add(&bar[XB_TOP], 1u);
            const unsigned tg = og / nx;
            if (og + 1u == (tg + 1u) * nx) xb_add(&bar[XB_TOPGEN], 1u);
            else XB_SPIN(xb_ld(&bar[XB_TOPGEN]) == tg, bar);
            __builtin_amdgcn_fence(__ATOMIC_ACQUIRE, "agent");
            xb_add(&bar[XB_XGEN(b.x)], 1u);
            asm volatile("s_waitcnt vmcnt(0)" ::: "memory");
        } else {
            XB_SPIN(xb_ld(&bar[XB_XGEN(b.x)]) == gen, bar);
            __builtin_amdgcn_fence(__ATOMIC_ACQUIRE, "agent");
            asm volatile("s_waitcnt vmcnt(0)" ::: "memory");
        }
    }
    __syncthreads();
}

struct Args { const float* in[20]; float* out; unsigned char* ws; };
typedef const __attribute__((address_space(4))) Args KA;
struct Frame {
    LAS unsigned char* lds;
    volatile LAS unsigned* MISC;
    gu32* ctl;
    int tid, lane, wave, vcu, G;
    KA* ka;
    float* out;
    unsigned char* ws;
};
__device__ __forceinline__ const float* in_ptr(KA* ka, int i) { asm volatile("" : "+s"(ka)); return ka->in[i]; }
#define INP(i) in_ptr(F.ka, (i))
#define WSP(T, off) ((T*)(F.ws + (off)))

__device__ __forceinline__ int q_next(Frame& F, int cw) {
    __syncthreads();
    if (F.tid == 0) F.MISC[0] = __hip_atomic_fetch_add(F.ctl + cw, 1u, RLX_AGENT);
    __syncthreads();
    return (int)F.MISC[0];
}

struct RowId   { __device__ __forceinline__ int operator()(int n) const { return n; } };
struct RowW1   { __device__ __forceinline__ int operator()(int n) const { return n < 8272 ? n : n + 176; } };
struct RowWup  { __device__ __forceinline__ int operator()(int n) const { const int u = n >= DFF, c = u ? n - DFF : n; return 256 * (c >> 7) + 128 * u + (c & 127); } };
__device__ __forceinline__ void tr_load(const float* W, int N, int kb, int nb, int lane, float (&t)[32]) {
    const int k0 = 64 * kb, nn = min(32 * nb + (lane & 31), N - 1);
    const GAS float* rp = (const GAS float*)W + (size_t)k0 * N;
    const unsigned lo = (unsigned)((lane >> 5) * N + nn);
#pragma unroll
    for (int i = 0; i < 32; ++i) t[i] = __builtin_nontemporal_load(rp + (size_t)(2 * i) * N + lo);
    __builtin_amdgcn_sched_barrier(0);
}
template <class RM>
__device__ __forceinline__ void tr_store(const float (&t)[32], int K, int N, bf16* WT, RM rm, LAS float* scr, int kb, int nb, int lane, const float* kscale) {
    const int k0 = 64 * kb, n0 = 32 * nb;
#pragma unroll
    for (int i = 0; i < 32; ++i) { const int kk = 2 * i + (lane >> 5); scr[kk * 33 + (lane & 31)] = t[i]; }
    LDS_WAIT(); asm volatile("" ::: "memory");
    const int c = lane & 7;
    f32x4 g0 = {1.f, 1.f, 1.f, 1.f}, g1 = g0;
    if (kscale) { g0 = *(const f32x4*)(kscale + k0 + 8 * c); g1 = *(const f32x4*)(kscale + k0 + 8 * c + 4); }
#pragma unroll
    for (int j = 0; j < 4; ++j) { const int n = (lane >> 3) + 8 * j; const LAS float* s = scr + (8 * c) * 33 + n;
        v4u o; o.x = cvt_pk_bf16(s[0 * 33] * g0[0], s[1 * 33] * g0[1]); o.y = cvt_pk_bf16(s[2 * 33] * g0[2], s[3 * 33] * g0[3]); o.z = cvt_pk_bf16(s[4 * 33] * g1[0], s[5 * 33] * g1[1]); o.w = cvt_pk_bf16(s[6 * 33] * g1[2], s[7 * 33] * g1[3]);
        if (n0 + n < N) *(GAS v4u*)(WT + (size_t)rm(n0 + n) * K + k0 + 8 * c) = o; }
    LDS_WAIT(); asm volatile("" ::: "memory");
}
template <class RM>
__device__ __forceinline__ void transpose_range(Frame& F, const float* W, int K, int N, bf16* WT, RM rm, const float* kscale, int it, int NGW, int nit);
template <class RM>
__device__ __forceinline__ void transpose_matrix(Frame& F, const float* W, int K, int N, bf16* WT, RM rm, const float* kscale = nullptr, int wg = -1, int nwg = 0, int kb0 = 0, int kb1 = -1) {
    const int gw = (wg < 0 ? F.vcu : wg) * NWAVES + F.wave, NGW = (wg < 0 ? F.G : nwg) * NWAVES;
    const int nnb = (N + 31) / 32, nit = (kb1 < 0 ? K / 64 : kb1) * nnb;
    transpose_range(F, W, K, N, WT, rm, kscale, kb0 * nnb + gw, NGW, nit);
}
template <class RM>
__device__ __forceinline__ void transpose_range(Frame& F, const float* W, int K, int N, bf16* WT, RM rm, const float* kscale, int it, int NGW, int nit) {
    LAS float* scr = (LAS float*)(F.lds + F.wave * 16384);
    const int nnb = (N + 31) / 32;
    if (it >= nit) return;
    const int n = (nit - it + NGW - 1) / NGW, last = it + (n - 1) * NGW;
    float t[32], u[32];
    tr_load(W, N, it / nnb, it % nnb, F.lane, t);
    for (int p = n >> 1; p > 0; --p) {
        const int i1 = it + NGW, i2 = min(i1 + NGW, last);
        tr_load(W, N, i1 / nnb, i1 % nnb, F.lane, u);
        tr_store(t, K, N, WT, rm, scr, it / nnb, it % nnb, F.lane, kscale);
        tr_load(W, N, i2 / nnb, i2 % nnb, F.lane, t);
        tr_store(u, K, N, WT, rm, scr, i1 / nnb, i1 % nnb, F.lane, kscale);
        it = i1 + NGW;
    }
    if (n & 1) tr_store(t, K, N, WT, rm, scr, last / nnb, last % nnb, F.lane, kscale);
}
__device__ __forceinline__ void rms_vals_to_bf16(const f32x4 (&v)[16], const float* g, bf16* orow, int lane) {
    float s = 0.f;
#pragma unroll
    for (int j = 0; j < 16; ++j) s += (v[j].x * v[j].x + v[j].y * v[j].y) + (v[j].z * v[j].z + v[j].w * v[j].w);
    const float r = 1.f / sqrtf(wave_sum(s) * (1.f / DM) + EPS);
    const GAS f32x4* gr = (const GAS f32x4*)g + lane;
    GAS v2u* o8 = (GAS v2u*)orow + lane;
#pragma unroll
    for (int j = 0; j < 16; ++j) { const f32x4 gg = gr[64 * j]; v2u w; w.x = cvt_pk_bf16(v[j].x * r * gg.x, v[j].y * r * gg.y); w.y = cvt_pk_bf16(v[j].z * r * gg.z, v[j].w * r * gg.w); o8[64 * j] = w; }
}
__device__ __forceinline__ void rms_row_to_bf16(const float* xrow, const float* g, bf16* orow, int lane) {
    const GAS f32x4* xr = (const GAS f32x4*)xrow + lane;
    f32x4 v[16]; float s = 0.f;
#pragma unroll
    for (int j = 0; j < 16; ++j) { v[j] = __builtin_nontemporal_load(&xr[64 * j]); s += (v[j].x * v[j].x + v[j].y * v[j].y) + (v[j].z * v[j].z + v[j].w * v[j].w); }
    const float r = 1.f / sqrtf(wave_sum(s) * (1.f / DM) + EPS);
    const GAS f32x4* gr = (const GAS f32x4*)g + lane;
    GAS v2u* o8 = (GAS v2u*)orow + lane;
#pragma unroll
    for (int j = 0; j < 16; ++j) { const f32x4 gg = gr[64 * j]; v2u w; w.x = cvt_pk_bf16(v[j].x * r * gg.x, v[j].y * r * gg.y); w.y = cvt_pk_bf16(v[j].z * r * gg.z, v[j].w * r * gg.w); o8[64 * j] = w; }
}
__device__ __forceinline__ void sincos_d(double x, double& s, double& c) {
    const double kf = __builtin_rint(x * 0.63661977236758134308);
    double r = __builtin_fma(-kf, 1.57079632679489655800e+00, x); r = __builtin_fma(-kf, 6.12323399573676603587e-17, r);
    const double r2 = r * r;
    double sp = -1.0 / 1307674368000.0; sp = sp * r2 + 1.0 / 6227020800.0; sp = sp * r2 - 1.0 / 39916800.0; sp = sp * r2 + 1.0 / 362880.0; sp = sp * r2 - 1.0 / 5040.0; sp = sp * r2 + 1.0 / 120.0; sp = sp * r2 - 1.0 / 6.0; sp = sp * r2 + 1.0;
    const double sn = r * sp;
    double cp = 1.0 / 20922789888000.0; cp = cp * r2 - 1.0 / 87178291200.0; cp = cp * r2 + 1.0 / 479001600.0; cp = cp * r2 - 1.0 / 3628800.0; cp = cp * r2 + 1.0 / 40320.0; cp = cp * r2 - 1.0 / 720.0; cp = cp * r2 + 1.0 / 24.0; cp = cp * r2 - 0.5; cp = cp * r2 + 1.0;
    const int k = ((int)kf) & 3;
    s = (k == 0) ? sn : (k == 1) ? cp : (k == 2) ? -sn : -cp;
    c = (k == 0) ? cp : (k == 1) ? -sn : (k == 2) ? -cp : sn;
}
__device__ __forceinline__ float inv_freq16(int j) {
    const float t[16] = {1.000000000e+00f, 4.403665960e-01f, 1.939227432e-01f, 8.539710194e-02f, 3.760603070e-02f, 1.656043902e-02f, 7.292664610e-03f, 3.211445874e-03f,
                         1.414213562e-03f, 6.227723788e-04f, 2.742481884e-04f, 1.207697351e-04f, 5.318296098e-05f, 2.341999971e-05f, 1.031338616e-05f, 4.541670478e-06f};
    float r = t[0];
#pragma unroll
    for (int i = 1; i < 16; ++i) r = (j == i) ? t[i] : r;
    return r;
}
__device__ __forceinline__ void p0_prologue(Frame& F) {
    const int gt = F.vcu * NTHREADS + F.tid, NGT = F.G * NTHREADS;
    const int gw = F.vcu * NWAVES + F.wave, NGW = F.G * NWAVES;
    transpose_matrix(F, INP(7), DM, INCOLS, WSP(bf16, WS_W1T), RowW1());
    { GAS v4u* z = (GAS v4u*)(F.ws + WS_W1T + (size_t)8272 * DM * 2); const int n16 = 176 * DM * 2 / 16;
      for (int i = gt; i < n16; i += NGT) z[i] = (v4u){0u, 0u, 0u, 0u}; }
    {
      const int sw = F.wave * F.G + F.vcu, np = gw < MP ? (MP - gw + NGW - 1) / NGW : 0, ns = sw < MS ? (MS - sw + NGW - 1) / NGW : 0;
      for (int i = 0; i < np + ns; ++i) { const int m = i < np ? gw + i * NGW : MP + sw + (i - np) * NGW;
        const float* xr = m < MP ? INP(0) + (size_t)m * DM : INP(1) + (size_t)(m - MP) * DM;
        rms_row_to_bf16(xr, INP(6), WSP(bf16, WS_H) + (size_t)m * DM, F.lane); } }
    {
      const int per_bi = 2048 * IDXD / 8;
      for (int i = gt; i < 32 * per_bi; i += NGT) { const int b = i / per_bi, r = i - b * per_bi;
          const GAS f32x4* si = (const GAS f32x4*)(INP(4)) + (size_t)i * 2;
          ((GAS v4u*)(F.ws + WS_KICAT))[((size_t)b * LCAT * IDXD) / 8 + r] = pack8(si[0], si[1]); }
      const int padk = 96 * KVW / 8, padi = 96 * IDXD / 8;
      for (int i = gt; i < 32 * padk; i += NGT) { const int b = i / padk, r = i - b * padk; const size_t d = ((size_t)(b * LCAT + 2080) * KVW) / 8 + r;
          ((GAS v4u*)(F.ws + WS_KCAT))[d] = (v4u){0u, 0u, 0u, 0u}; ((GAS v4u*)(F.ws + WS_VCAT))[d] = (v4u){0u, 0u, 0u, 0u}; }
      for (int i = gt; i < 32 * padi; i += NGT) { const int b = i / padi, r = i - b * padi;
          ((GAS v4u*)(F.ws + WS_KICAT))[((size_t)(b * LCAT + 2080) * IDXD) / 8 + r] = (v4u){0u, 0u, 0u, 0u}; } }
    for (int i = gt; i < 2080 * 24; i += NGT) {
        const int pos = i / 24, j = i - pos * 24;
        const float f = j < 16 ? inv_freq16(j) : inv_freq16(2 * (j - 16));
        const float ang = (float)pos * f; double s, c; sincos_d((double)ang, s, c);
        float* dst = j < 16 ? WSP(float, WS_TABQ) + (pos * 16 + j) * 2 : WSP(float, WS_TABI) + (pos * 8 + (j - 16)) * 2;
        dst[0] = (float)c; dst[1] = (float)s;
    }
    for (int i = gt; i < 8 * 128 * 128; i += NGT) { const int qi = (i >> 7) & 127, kj = i & 127; const float w = INP(9)[i];
        WSP(bf16, WS_WSB)[i] = f2bf1(((kj >> 6) <= (qi >> 6)) ? w : 0.f); }
}

using pg8::Unit;

struct EpiProj {
    static constexpr bool PERM = true, AFTER_DRAIN = false;
    unsigned char* ws; float* out;
    __device__ __forceinline__ void operator()(const f32x4 (&acc)[2][2][4][2], const Unit& u, int wr, int wc, int fr, int fq) const {
        const int pn = u.pn, pm = u.pm;
        bf16* const U = (bf16*)(ws + WS_U); bf16* const V = (bf16*)(ws + WS_V); bf16* const Q = (bf16*)(ws + WS_Q); bf16* const QI = (bf16*)(ws + WS_QI); bf16* const SA = (bf16*)(ws + WS_SA); bf16* const SB = (bf16*)(ws + WS_SB);
        bf16* const KP = (bf16*)(ws + WS_KP); bf16* const VP = (bf16*)(ws + WS_VP); bf16* const KIP = (bf16*)(ws + WS_KIP); bf16* const KCAT = (bf16*)(ws + WS_KCAT); bf16* const VCAT = (bf16*)(ws + WS_VCAT); bf16* const KICAT = (bf16*)(ws + WS_KICAT);
        float* const WI = (float*)(ws + WS_WI); float* const ssq = (float*)(ws + WS_CTL) + CW_SSQ; const float* const tabQ = (const float*)(ws + WS_TABQ); const float* const tabI = (const float*)(ws + WS_TABI);
        const int row0 = pm * 256 + wr * 64 + fr, c0 = wc * 32 + 8 * fq;
        const bool samp = pm >= 64;
        if (pn < 8 || (pn >= 33)) {
            bf16* base; int ld, cb; bool sg;
            if (pn < 8) { base = U; ld = DA; cb = pn * 256; sg = false; }
            else if (pn < 49) { base = SA; ld = DM; cb = (pn - 33) * 256; sg = true; }
            else { base = SB; ld = DM; cb = (pn - 49) * 256; sg = true; }
#pragma unroll
            for (int ai = 0; ai < 2; ++ai)
#pragma unroll
                for (int m = 0; m < 4; ++m) { bf16* rowp = base + (size_t)(row0 + ai * 128 + m * 16) * ld + cb + c0;
#pragma unroll
                    for (int bj = 0; bj < 2; ++bj) { f32x4 v0 = acc[ai][bj][m][0], v1 = acc[ai][bj][m][1];
                        if (sg) {
#pragma unroll
                            for (int i = 0; i < 4; ++i) { v0[i] = sigmoidf_(v0[i]); v1[i] = sigmoidf_(v1[i]); } }
                        *(v4u*)(rowp + bj * 128) = pack8(v0, v1); } }
        } else if (pn < 16) {
            const int cb = (pn - 8) * 256;
#pragma unroll
            for (int ai = 0; ai < 2; ++ai)
#pragma unroll
                for (int m = 0; m < 4; ++m) { const int row = row0 + ai * 128 + m * 16; bf16* rowp = V + (size_t)row * DA + cb + c0; float s = 0.f;
#pragma unroll
                    for (int bj = 0; bj < 2; ++bj) { const f32x4 v0 = acc[ai][bj][m][0], v1 = acc[ai][bj][m][1];
                        s += (v0[0] * v0[0] + v0[1] * v0[1]) + (v0[2] * v0[2] + v0[3] * v0[3]) + (v1[0] * v1[0] + v1[1] * v1[1]) + (v1[2] * v1[2] + v1[3] * v1[3]);
                        *(v4u*)(rowp + bj * 128) = pack8(v0, v1); }
                    s += __shfl_xor(s, 16); s += __shfl_xor(s, 32);
                    if (fq == 0) __hip_atomic_fetch_add(ssq + row, s, RLX_AGENT); }
        } else if (pn < 28) {
            const bool rope = pn < 26, isq = pn < 24, isk = (pn == 24 || pn == 25);
#pragma unroll
            for (int ai = 0; ai < 2; ++ai)
#pragma unroll
                for (int m = 0; m < 4; ++m) { const int row = row0 + ai * 128 + m * 16; const int pos = samp ? 2048 + (row & 31) : (row & 2047);
                    f32x4 t0, t1, t2, t3;
                    if (rope && wc == 0) { const f32x4* tp = (const f32x4*)(tabQ + (pos * 16 + 8 * (fq & 1)) * 2); t0 = tp[0]; t1 = tp[1]; t2 = tp[2]; t3 = tp[3]; }
#pragma unroll
                    for (int bj = 0; bj < 2; ++bj) { f32x4 v0 = acc[ai][bj][m][0], v1 = acc[ai][bj][m][1];
                        if (rope && wc == 0) {
                            const float sg = fq < 2 ? -1.f : 1.f;
                            const float cs[8] = {t0[0], t0[2], t1[0], t1[2], t2[0], t2[2], t3[0], t3[2]}, sn[8] = {t0[1], t0[3], t1[1], t1[3], t2[1], t2[3], t3[1], t3[3]};
#pragma unroll
                            for (int i = 0; i < 4; ++i) { const float p0 = __shfl_xor(v0[i], 32), p1 = __shfl_xor(v1[i], 32);
                                v0[i] = v0[i] * cs[i] + sg * p0 * sn[i]; v1[i] = v1[i] * cs[4 + i] + sg * p1 * sn[4 + i]; } }
                        const v4u w = pack8(v0, v1);
                        if (isq) { *(v4u*)(Q + (size_t)row * QW + (pn - 16) * 256 + bj * 128 + c0) = w; }
                        else { const int kc = ((pn - 24) & 1) * 256 + bj * 128 + c0;
                            bf16* dp = isk ? (samp ? KCAT : KP) : (samp ? VCAT : VP);
                            const int r2 = row - MP;
                            const size_t drow = samp ? (size_t)((r2 >> 5) * LCAT + 2048 + (r2 & 31)) : (size_t)row;
                            *(v4u*)(dp + drow * KVW + kc) = w;
                            float* op = out + (isk ? (samp ? O_KS : O_KP) : (samp ? O_VS : O_VP)) + (size_t)(samp ? r2 : row) * KVW + kc;
                            *(f32x4*)op = v0; *(f32x4*)(op + 4) = v1; } } }
        } else if (pn < 32) {
#pragma unroll
            for (int ai = 0; ai < 2; ++ai)
#pragma unroll
                for (int m = 0; m < 4; ++m) { const int row = row0 + ai * 128 + m * 16; const int pos = samp ? 2048 + (row & 31) : (row & 2047);
                    f32x4 t0, t1, t2, t3;
                    if ((wc & 1) == 0) { const f32x4* tp = (const f32x4*)(tabI + pos * 16); t0 = tp[0]; t1 = tp[1]; t2 = tp[2]; t3 = tp[3]; }
#pragma unroll
                    for (int bj = 0; bj < 2; ++bj) { f32x4 v0 = acc[ai][bj][m][0], v1 = acc[ai][bj][m][1];
                        if ((wc & 1) == 0) {
                            const float sg = fq == 0 ? -1.f : 1.f;
                            const float cs[8] = {t0[0], t0[2], t1[0], t1[2], t2[0], t2[2], t3[0], t3[2]}, sn[8] = {t0[1], t0[3], t1[1], t1[3], t2[1], t2[3], t3[1], t3[3]};
#pragma unroll
                            for (int i = 0; i < 4; ++i) { const float p0 = __shfl_xor(v0[i], 16), p1 = __shfl_xor(v1[i], 16);
                                const float r0 = v0[i] * cs[i] + sg * p0 * sn[i], r1 = v1[i] * cs[4 + i] + sg * p1 * sn[4 + i];
                                v0[i] = fq < 2 ? r0 : v0[i]; v1[i] = fq < 2 ? r1 : v1[i]; } }
                        *(v4u*)(QI + (size_t)row * IDXW + (pn - 28) * 256 + bj * 128 + c0) = pack8(v0, v1); } }
        } else {
#pragma unroll
            for (int ai = 0; ai < 2; ++ai)
#pragma unroll
                for (int m = 0; m < 4; ++m) { const int row = row0 + ai * 128 + m * 16; const int pos = samp ? 2048 + (row & 31) : (row & 2047);
                    f32x4 v0 = acc[ai][0][m][0], v1 = acc[ai][0][m][1];
                    if (wc == 0) {
                        const f32x4* tp = (const f32x4*)(tabI + pos * 16); const f32x4 t0 = tp[0], t1 = tp[1], t2 = tp[2], t3 = tp[3];
                        const float sg = fq == 0 ? -1.f : 1.f;
                        const float cs[8] = {t0[0], t0[2], t1[0], t1[2], t2[0], t2[2], t3[0], t3[2]}, sn[8] = {t0[1], t0[3], t1[1], t1[3], t2[1], t2[3], t3[1], t3[3]};
#pragma unroll
                        for (int i = 0; i < 4; ++i) { const float p0 = __shfl_xor(v0[i], 16), p1 = __shfl_xor(v1[i], 16);
                            const float r0 = v0[i] * cs[i] + sg * p0 * sn[i], r1 = v1[i] * cs[4 + i] + sg * p1 * sn[4 + i];
                            v0[i] = fq < 2 ? r0 : v0[i]; v1[i] = fq < 2 ? r1 : v1[i]; } }
                    if (wc < 2) { const int r2 = row - MP;
                        const size_t drow = samp ? (size_t)((r2 >> 5) * LCAT + 2048 + (r2 & 31)) : (size_t)row;
                        *(v4u*)((samp ? KICAT : KIP) + drow * IDXD + c0) = pack8(v0, v1);
                        float* op = out + (samp ? O_KIS : O_KIP) + (size_t)(samp ? r2 : row) * IDXD + c0;
                        *(f32x4*)op = v0; *(f32x4*)(op + 4) = v1; }
                    else if (wc == 2 && fq < 2) { float* wp = WI + (size_t)row * 16 + 8 * fq; *(f32x4*)wp = v0 * 0.03125f; *(f32x4*)(wp + 4) = v1 * 0.03125f; } }
        }
    }
};

struct ProjOrder : pg8::StaticOrder {
    __device__ __forceinline__ bool next(int i, Unit& u) const { if (!pg8::StaticOrder::next(i, u)) return false; if (u.pn >= 32) u.pn += 1; return true; }
};
struct ThinOrder {
    int c;
    __device__ __forceinline__ bool next(int i, Unit& u) const { if (i > 0 || c >= 204) return false; u.pm = c % 68; u.pn = 32; return true; }
    __device__ __forceinline__ void a_ready(const Unit&) const {}
    __device__ __forceinline__ void done(const Unit&) const {}
};
struct EpiThinPart {
    static constexpr bool PERM = true, AFTER_DRAIN = false;
    float* part;
    __device__ __forceinline__ void operator()(const f32x4 (&acc)[2][2][4][2], const Unit& u, int wr, int wc, int fr, int fq) const {
        const int row0 = u.pm * 256 + wr * 64 + fr, c0 = wc * 32 + 8 * fq;
#pragma unroll
        for (int ai = 0; ai < 2; ++ai)
#pragma unroll
            for (int m = 0; m < 4; ++m) { float* p = part + (size_t)(row0 + ai * 128 + m * 16) * 128 + c0; *(f32x4*)p = acc[ai][0][m][0]; *(f32x4*)(p + 4) = acc[ai][0][m][1]; }
    }
};
struct EpiMergeA {
    static constexpr bool PERM = true, AFTER_DRAIN = false;
    unsigned char* ws; bf16* P;
    __device__ __forceinline__ void operator()(const f32x4 (&acc)[2][2][4][2], const Unit& u, int wr, int wc, int fr, int fq) const {
        const bf16* const SA = (const bf16*)(ws + WS_SA);
        const int row0 = u.pm * 256 + wr * 64 + fr, col0 = u.pn * 256 + wc * 32 + 8 * fq;
#pragma unroll
        for (int ai = 0; ai < 2; ++ai)
#pragma unroll
            for (int m = 0; m < 4; ++m) { const size_t off = (size_t)(row0 + ai * 128 + m * 16) * DM + col0;
#pragma unroll
                for (int bj = 0; bj < 2; ++bj) { const v4u g = *(const v4u*)(SA + off + bj * 128); const f32x4 a0 = acc[ai][bj][m][0], a1 = acc[ai][bj][m][1];
                    const f32x4 y0 = {a0[0] * bf_lo(g.x), a0[1] * bf_hi(g.x), a0[2] * bf_lo(g.y), a0[3] * bf_hi(g.y)};
                    const f32x4 y1 = {a1[0] * bf_lo(g.z), a1[1] * bf_hi(g.z), a1[2] * bf_lo(g.w), a1[3] * bf_hi(g.w)};
                    *(v4u*)(P + off + bj * 128) = pack8(y0, y1); } }
    }
};
struct EpiMergeB {
    static constexpr bool PERM = true, AFTER_DRAIN = false;
    unsigned char* ws; const bf16* P;
    __device__ __forceinline__ void operator()(const f32x4 (&acc)[2][2][4][2], const Unit& u, int wr, int wc, int fr, int fq) const {
        const bf16* const SB = (const bf16*)(ws + WS_SB); bf16* const Y = (bf16*)(ws + WS_H);
        const int row0 = u.pm * 256 + wr * 64 + fr, col0 = u.pn * 256 + wc * 32 + 8 * fq;
#pragma unroll
        for (int ai = 0; ai < 2; ++ai)
#pragma unroll
            for (int m = 0; m < 4; ++m) { const size_t off = (size_t)(row0 + ai * 128 + m * 16) * DM + col0;
#pragma unroll
                for (int bj = 0; bj < 2; ++bj) { const v4u g = *(const v4u*)(SB + off + bj * 128); const v4u p = *(const v4u*)(P + off + bj * 128);
                    const f32x4 a0 = acc[ai][bj][m][0], a1 = acc[ai][bj][m][1];
                    const f32x4 y0 = {bf_lo(p.x) + a0[0] * bf_lo(g.x), bf_hi(p.x) + a0[1] * bf_hi(g.x), bf_lo(p.y) + a0[2] * bf_lo(g.y), bf_hi(p.y) + a0[3] * bf_hi(g.y)};
                    const f32x4 y1 = {bf_lo(p.z) + a1[0] * bf_lo(g.z), bf_hi(p.z) + a1[1] * bf_hi(g.z), bf_lo(p.w) + a1[2] * bf_lo(g.w), bf_hi(p.w) + a1[3] * bf_hi(g.w)};
                    *(v4u*)(Y + off + bj * 128) = pack8(y0, y1); } }
    }
};
__device__ __forceinline__ int perm_row(int p) { const int id = p >> 3, off = p & 7; return 128 * (off >> 2) + 64 * (id >> 4) + 16 * (off & 3) + (id & 15); }
struct EpiX1 {
    static constexpr bool PERM = true, AFTER_DRAIN = false;
    unsigned char* ws; KA* ka;
    __device__ __forceinline__ void operator()(const f32x4 (&acc)[2][2][4][2], const Unit& u, int wr, int wc, int fr, int fq) const {
        bf16* const X1B = (bf16*)(ws + WS_X1B); float* const ssq2 = (float*)(ws + WS_CTL) + CW_SSQ2;
        const float* const x = in_ptr(ka, 0);
        const int col0 = u.pn * 256 + wc * 32 + 8 * fq;
#pragma unroll
        for (int ai = 0; ai < 2; ++ai)
#pragma unroll
            for (int m = 0; m < 4; ++m) { const int p = ai * 128 + wr * 64 + m * 16 + fr, row = u.pm * 256 + p; float s = 0.f;
                const float* xr = x + (size_t)row * DM + col0; bf16* dr = X1B + (size_t)(u.pm * 256 + perm_row(p)) * DM + col0;
#pragma unroll
                for (int bj = 0; bj < 2; ++bj) { const f32x4 v0 = *(const f32x4*)(xr + bj * 128) + acc[ai][bj][m][0], v1 = *(const f32x4*)(xr + bj * 128 + 4) + acc[ai][bj][m][1];
                    s += (v0[0] * v0[0] + v0[1] * v0[1]) + (v0[2] * v0[2] + v0[3] * v0[3]) + (v1[0] * v1[0] + v1[1] * v1[1]) + (v1[2] * v1[2] + v1[3] * v1[3]);
                    *(v4u*)(dr + bj * 128) = pack8(v0, v1); }
                s += __shfl_xor(s, 16); s += __shfl_xor(s, 32);
                if (fq == 0) __hip_atomic_fetch_add(ssq2 + row, s, RLX_AGENT); }
    }
};
struct EpiX2 {
    static constexpr bool PERM = true, AFTER_DRAIN = false;
    unsigned char* ws;
    __device__ __forceinline__ void operator()(const f32x4 (&acc)[2][2][4][2], const Unit& u, int wr, int wc, int fr, int fq) const {
        const bf16* const X1B = (const bf16*)(ws + WS_X1B); bf16* const X2B = (bf16*)(ws + WS_X2B);
        const int col0 = u.pn * 256 + wc * 32 + 8 * fq;
#pragma unroll
        for (int ai = 0; ai < 2; ++ai)
#pragma unroll
            for (int m = 0; m < 4; ++m) { const int p = ai * 128 + wr * 64 + m * 16 + fr;
                const bf16* sr = X1B + (size_t)(u.pm * 256 + perm_row(p)) * DM + col0; bf16* dr = X2B + (size_t)(u.pm * 256 + p) * DM + col0;
#pragma unroll
                for (int bj = 0; bj < 2; ++bj) { const v4u x = *(const v4u*)(sr + bj * 128); const f32x4 a0 = acc[ai][bj][m][0], a1 = acc[ai][bj][m][1];
                    const f32x4 v0 = {bf_lo(x.x) + a0[0], bf_hi(x.x) + a0[1], bf_lo(x.y) + a0[2], bf_hi(x.y) + a0[3]};
                    const f32x4 v1 = {bf_lo(x.z) + a1[0], bf_hi(x.z) + a1[1], bf_lo(x.w) + a1[2], bf_hi(x.w) + a1[3]};
                    *(v4u*)(dr + bj * 128) = pack8(v0, v1); } }
    }
};
constexpr int UP_SLOT = 5120;
struct UpOrder : pg8::StaticOrder {
    unsigned char* ws; KA* ka; LAS unsigned char* par; mutable int k;
    gu32* ctl; volatile LAS unsigned* pfw; mutable int lastchunk; int dyn, x, j, ch, nch;
    __device__ __forceinline__ void initd(gu32* ctl_, volatile LAS unsigned* pfw_) { ctl = ctl_; pfw = pfw_; dyn = (G & 7) == 0 && G >= 8; x = c & 7; j = c >> 3; ch = G >> 3; nch = dyn ? (nwg + ch - 1) / ch : 0; lastchunk = 0; }
    __device__ __forceinline__ bool next(int i, Unit& u) const {
        if (!dyn) return pg8::StaticOrder::next(i, u);
        if (i >= 3 && lastchunk >= nch - 1) return false;
        const int tid = (int)threadIdx.x;
        gu32* cl = ctl + CW_CL + x * 256;
        if (i + 2 >= 3 && (i + 2) % ch == j && tid == 0) {
            if (i + 1 >= 3) while ((__hip_atomic_load(cl + i + 1, RLX_AGENT) >> 16) != (unsigned)(i + 1)) __builtin_amdgcn_s_sleep(1);
            const unsigned v = __hip_atomic_fetch_add(ctl + CW_DQ, 1u, RLX_AGENT);
            __hip_atomic_store(cl + i + 2, ((unsigned)(i + 2) << 16) | (24u + v + 1u), RLX_AGENT);
            asm volatile("s_waitcnt vmcnt(0)" ::: "memory");
        }
        int chunk;
        if (i < 3) chunk = 8 * i + x;
        else { unsigned v = pfw[i & 1];
            while ((v >> 16) != (unsigned)i) { v = __hip_atomic_load(cl + i, RLX_AGENT); if ((v >> 16) != (unsigned)i) __builtin_amdgcn_s_sleep(1); }
            chunk = (int)(v & 0xffffu) - 1; }
        chunk = __builtin_amdgcn_readfirstlane(chunk);
        lastchunk = chunk;
        if (i + 1 >= 3 && tid == 0) __builtin_amdgcn_global_load_lds((const unsigned*)(cl + i + 1), (LAS unsigned*)(pfw + ((i + 1) & 1)), 4, 0, 17);
        const int wgid = ch * chunk + j;
        if (chunk >= nch || wgid >= nwg) return false;
        const int nig = pg8::WGM * nN, gid = wgid / nig, fm = gid * pg8::WGM, gsz = (nM - fm) < pg8::WGM ? (nM - fm) : pg8::WGM;
        u.pm = fm + ((wgid % nig) % gsz); u.pn = (wgid % nig) / gsz; return true;
    }
    __device__ __forceinline__ void a_ready(const Unit& u) const {
        const int wid = __builtin_amdgcn_readfirstlane((int)threadIdx.x >> 6), lane = (int)threadIdx.x & 63;
        LAS unsigned char* slot = par + (k & 1) * UP_SLOT; ++k;
        if (wid < 4) { const int arr = 2 * wid + (lane >> 5), col = 4 * (lane & 31);
            const float* base = (arr & 3) < 3 ? in_ptr(ka, 16) + (size_t)(arr & 3) * NUP : in_ptr(ka, 17);
            __builtin_amdgcn_global_load_lds((const unsigned*)(base + ((arr >> 2) ? DFF : 0) + 128 * u.pn + col), (LAS unsigned*)(slot + wid * 1024), 16, 0, 0); }
        else if (wid == 4) __builtin_amdgcn_global_load_lds((const unsigned*)((const float*)(ws + WS_CTL) + CW_SSQ2 + 256 * u.pm + 4 * lane), (LAS unsigned*)(slot + 4096), 16, 0, 0);
    }
};
struct EpiUp {
    static constexpr bool PERM = true, AFTER_DRAIN = false;
    unsigned char* ws; float* out; KA* ka; LAS unsigned char* par; mutable int k;
    __device__ __forceinline__ void operator()(const f32x4 (&acc)[2][2][4][2], const Unit& u, int wr, int wc, int fr, int fq) const {
        bf16* const ACT = (bf16*)(ws + WS_ACT); float* const ZF = (float*)(ws + WS_H); float* const ZL = ZF + (size_t)128 * 2 * NUP;
        const float* const state = in_ptr(ka, 5);
        const LAS float* const PR = (const LAS float*)(par + (k & 1) * UP_SLOT); ++k;
        const int pm = u.pm, pn = u.pn, id = wr * 16 + fr, beta = 2 * pm + wr;
        const bool samp = pm >= 64;
        {
            f32x4 (&a)[2][2][4][2] = const_cast<f32x4 (&)[2][2][4][2]>(acc);
            const LAS float* sq = PR + 1024 + 8 * id;
#pragma unroll
            for (int ai = 0; ai < 2; ++ai)
#pragma unroll
                for (int m = 0; m < 4; ++m) { const float r = __builtin_amdgcn_rsqf(sq[4 * ai + m] * (1.f / DM) + EPS);
#pragma unroll
                    for (int bj = 0; bj < 2; ++bj)
#pragma unroll
                        for (int n = 0; n < 2; ++n) { a[ai][bj][m][n] *= r; asm volatile("" : "+v"(a[ai][bj][m][n])); } }
            asm volatile("" ::: "memory"); }
        const int bs = 8 * (pm - 64) + (id >> 2);
#pragma unroll
        for (int n = 0; n < 2; ++n) {
            const int cl = wc * 32 + 8 * fq + 4 * n, cg = pn * 128 + cl, cu = DFF + cg;
            const f32x4 w0g = *(const LAS f32x4*)(PR + cl), w1g = *(const LAS f32x4*)(PR + 128 + cl), w2g = *(const LAS f32x4*)(PR + 256 + cl), bg = *(const LAS f32x4*)(PR + 384 + cl);
            const f32x4 w0u = *(const LAS f32x4*)(PR + 512 + cl), w1u = *(const LAS f32x4*)(PR + 640 + cl), w2u = *(const LAS f32x4*)(PR + 768 + cl), bu = *(const LAS f32x4*)(PR + 896 + cl);
            const f32x4 g6 = acc[1][0][2][n], g7 = acc[1][0][3][n], u6 = acc[1][1][2][n], u7 = acc[1][1][3][n];
            f32x4 pg2, pg1, pu2, pu1;
#pragma unroll
            for (int i = 0; i < 4; ++i) { pg2[i] = __shfl_up(g6[i], 1); pg1[i] = __shfl_up(g7[i], 1); pu2[i] = __shfl_up(u6[i], 1); pu1[i] = __shfl_up(u7[i], 1); }
            bool defer = false;
            if (!samp) {
                if (fr == 0) {
                    if ((beta & 15) == 0) { pg2 = (f32x4){0.f, 0.f, 0.f, 0.f}; pg1 = pg2; pu2 = pg2; pu1 = pg2; }
                    else { defer = true; float* zf = ZF + (size_t)beta * 2 * NUP;
                        *(f32x4*)(zf + cg) = acc[0][0][0][n]; *(f32x4*)(zf + NUP + cg) = acc[0][0][1][n]; *(f32x4*)(zf + cu) = acc[0][1][0][n]; *(f32x4*)(zf + NUP + cu) = acc[0][1][1][n]; }
                }
                if (fr == 15) { float* zl = ZL + (size_t)beta * 2 * NUP;
                    *(f32x4*)(zl + cg) = g6; *(f32x4*)(zl + NUP + cg) = g7; *(f32x4*)(zl + cu) = u6; *(f32x4*)(zl + NUP + cu) = u7;
                    if ((beta & 15) == 15) { float* op = out + O_CP + (size_t)(beta >> 4) * 2 * NUP;
                        *(f32x4*)(op + cg) = g6; *(f32x4*)(op + NUP + cg) = g7; *(f32x4*)(op + cu) = u6; *(f32x4*)(op + NUP + cu) = u7; } }
            } else {
                if ((fr & 3) == 0) { const float* sp = state + (size_t)bs * 2 * NUP;
                    pg2 = *(const f32x4*)(sp + cg); pg1 = *(const f32x4*)(sp + NUP + cg); pu2 = *(const f32x4*)(sp + cu); pu1 = *(const f32x4*)(sp + NUP + cu); }
                if ((fr & 3) == 3) { float* op = out + O_CS + (size_t)bs * 2 * NUP;
                    *(f32x4*)(op + cg) = g6; *(f32x4*)(op + NUP + cg) = g7; *(f32x4*)(op + cu) = u6; *(f32x4*)(op + NUP + cu) = u7; }
            }
            bf16* ap = ACT + (size_t)(pm * 256 + 8 * id) * DFF + cg;
#pragma unroll
            for (int off = 0; off < 8; ++off) {
                const f32x4 zg = acc[off >> 2][0][off & 3][n], zu = acc[off >> 2][1][off & 3][n];
                const f32x4 zg1 = off >= 1 ? acc[(off + 7) >> 2 & 1][0][(off + 7) & 3][n] : pg1, zu1 = off >= 1 ? acc[(off + 7) >> 2 & 1][1][(off + 7) & 3][n] : pu1;
                const f32x4 zg2 = off >= 2 ? acc[(off + 6) >> 2 & 1][0][(off + 6) & 3][n] : (off == 1 ? pg1 : pg2), zu2 = off >= 2 ? acc[(off + 6) >> 2 & 1][1][(off + 6) & 3][n] : (off == 1 ? pu1 : pu2);
                const f32x4 c_g = bg + w0g * zg2 + w1g * zg1 + w2g * zg, c_u = bu + w0u * zu2 + w1u * zu1 + w2u * zu;
                f32x4 a;
#pragma unroll
                for (int i = 0; i < 4; ++i) a[i] = c_g[i] * sigmoidf_(c_g[i]) * c_u[i];
                v2u w; w.x = cvt_pk_bf16(a[0], a[1]); w.y = cvt_pk_bf16(a[2], a[3]);
                if (!(defer && off < 2)) *(v2u*)(ap + (size_t)off * DFF) = w;
            }
            asm volatile("" ::: "memory");
        }
    }
};

struct EpiNull {
    static constexpr bool PERM = true, AFTER_DRAIN = false;
    __device__ __forceinline__ void operator()(const f32x4 (&acc)[2][2][4][2], const Unit& u, int wr, int wc, int fr, int fq) const {
#pragma unroll
        for (int ai = 0; ai < 2; ++ai)
#pragma unroll
            for (int bj = 0; bj < 2; ++bj)
#pragma unroll
                for (int m = 0; m < 4; ++m)
#pragma unroll
                    for (int n = 0; n < 2; ++n) asm volatile("" :: "v"(acc[ai][bj][m][n]));
    }
};

struct RemOrder {
    int c;
    __device__ __forceinline__ bool next(int i, Unit& u) const { if (i > 0) return false; u.pm = 64 + ((c & 63) >> 4); u.pn = c & 15; return true; }
    __device__ __forceinline__ void a_ready(const Unit&) const {}
    __device__ __forceinline__ void done(const Unit&) const {}
};
struct EpiPart {
    static constexpr bool PERM = false, AFTER_DRAIN = false;
    float* part;
    __device__ __forceinline__ void operator()(const f32x4 (&acc)[2][2][4][2], const Unit& u, int wr, int wc, int fr, int fq) const {
        const int row0 = (u.pm - 64) * 256 + wr * 64 + fr, col0 = u.pn * 256 + wc * 32 + 4 * fq;
#pragma unroll
        for (int ai = 0; ai < 2; ++ai)
#pragma unroll
            for (int m = 0; m < 4; ++m) { const size_t off = (size_t)(row0 + ai * 128 + m * 16) * DM + col0;
#pragma unroll
                for (int bj = 0; bj < 2; ++bj)
#pragma unroll
                    for (int n = 0; n < 2; ++n) *(f32x4*)(part + off + bj * 128 + n * 16) = acc[ai][bj][m][n]; }
    }
};

constexpr int VT_PITCH = 272;
__device__ __forceinline__ void gmlp_item(Frame& F, int item, bool dry = false) {
    const bool samp = item >= 1024;
    int tid_ = F.tid; asm volatile("" : "+v"(tid_));
    const int tid = tid_, lane = tid & 63;
    const int g = item & 7;
    const int row0 = samp ? MP + 32 * ((item - 1024) >> 3) : 128 * (item >> 3);
    LAS unsigned char* VT = F.lds;
    const bf16* Vb = WSP(bf16, WS_V); const bf16* Ub = WSP(bf16, WS_U); bf16* Ob = dry ? (bf16*)F.out : WSP(bf16, WS_U);
    const float* ssq = (const float*)(F.ctl + CW_SSQ);
    const float* gn = INP(8);
    { const int JB = samp ? 32 : 128, j = tid & (JB - 1), cq = samp ? (tid >> 5) : (tid >> 7), ncq = samp ? 16 : 4, npass = 32 / ncq;
      const int row = row0 + j;
      const float rs = 1.f / sqrtf(ssq[row] * (1.f / DA) + EPS);
      v4u vv[8];
#pragma unroll
      for (int p = 0; p < 8; ++p) if (p < npass) vv[p] = *(const v4u*)(Vb + (size_t)row * DA + 256 * g + 8 * (cq + ncq * p));
#pragma unroll
      for (int p = 0; p < 8; ++p) { if (p >= npass) break; const int c8 = cq + ncq * p, col = 256 * g + 8 * c8;
          const v4u v = vv[p];
          const f32x4 g0 = *(const f32x4*)(gn + col), g1 = *(const f32x4*)(gn + col + 4);
          float x[8] = {bf_lo(v.x) * rs * g0[0], bf_hi(v.x) * rs * g0[1], bf_lo(v.y) * rs * g0[2], bf_hi(v.y) * rs * g0[3], bf_lo(v.z) * rs * g1[0], bf_hi(v.z) * rs * g1[1], bf_lo(v.w) * rs * g1[2], bf_hi(v.w) * rs * g1[3]};
          if (samp) { float* op = F.out + O_GV + (size_t)(row - MP) * DA + col; *(f32x4*)op = (f32x4){x[0], x[1], x[2], x[3]}; *(f32x4*)(op + 4) = (f32x4){x[4], x[5], x[6], x[7]}; }
#pragma unroll
          for (int e = 0; e < 8; ++e) *(LAS bf16*)(VT + (8 * c8 + e) * VT_PITCH + 2 * j) = f2bf1(x[e]); } }
    __syncthreads();
    const int li = lane & 15, lq = lane >> 4;
    f32x4 acc[2][8];
#pragma unroll
    for (int db = 0; db < 2; ++db)
#pragma unroll
        for (int ib = 0; ib < 8; ++ib) acc[db][ib] = (f32x4){0.f, 0.f, 0.f, 0.f};
    bf16x8 af[2][4];
#pragma unroll
    for (int db = 0; db < 2; ++db)
#pragma unroll
        for (int ks = 0; ks < 4; ++ks) af[db][ks] = *(const LAS bf16x8*)(VT + (32 * F.wave + 16 * db + li) * VT_PITCH + (32 * ks + 8 * lq) * 2);
    const bf16* Wg = WSP(bf16, WS_WSB) + (size_t)g * 128 * 128;
#pragma unroll
    for (int ib = 0; ib < 8; ++ib) {
        if (samp && ib >= 2) continue;
#pragma unroll
        for (int ks = 0; ks < 4; ++ks) {
            if (ks >= (ib < 4 ? 2 : 4)) continue;
            if (samp && ks >= 1) continue;
            const bf16x8 bfr = *(const bf16x8*)(Wg + (16 * ib + li) * 128 + 32 * ks + 8 * lq);
#pragma unroll
            for (int db = 0; db < 2; ++db) acc[db][ib] = __builtin_amdgcn_mfma_f32_16x16x32_bf16(af[db][ks], bfr, acc[db][ib], 0, 0, 0);
        }
    }
    const float* gb = INP(10) + g * 128;
#pragma unroll
    for (int ib = 0; ib < 8; ++ib) {
        if (samp && ib >= 2) continue;
        const int i = 16 * ib + li; const float bias = gb[i];
#pragma unroll
        for (int db = 0; db < 2; ++db) { const size_t uo = (size_t)(row0 + i) * DA + 256 * g + 32 * F.wave + 16 * db + 4 * lq; bf16* up = Ob + uo;
            const v2u uu = *(const v2u*)(Ub + uo); const f32x4 s = acc[db][ib];
            v2u w; w.x = cvt_pk_bf16(bf_lo(uu.x) * (s[0] + bias), bf_hi(uu.x) * (s[1] + bias)); w.y = cvt_pk_bf16(bf_lo(uu.y) * (s[2] + bias), bf_hi(uu.y) * (s[3] + bias));
            *(v2u*)up = w; }
    }
}

template <int NTL>
__device__ __forceinline__ unsigned long long select_query(const float* srow, int lane, int nvalid) {
    int nvq = nvalid; asm volatile("" : "+s"(nvq));
    int ln = lane; asm volatile("" : "+v"(ln));
    const float* slane = srow + ln;
    unsigned key[NTL];
#pragma unroll
    for (int i = 0; i < NTL; ++i) { float v = slane[64 * i]; v = (64 * i + ln < nvq) ? v : -__builtin_inff();
        const unsigned ub = __float_as_uint(v); key[i] = (ub & 0x80000000u) ? ~ub : (ub | 0x80000000u); }
    unsigned T = 0u; bool exact = false;
    for (int bit = 31; bit >= 0; --bit) {
        const unsigned cand = T | (1u << bit); int cnt = 0;
#pragma unroll
        for (int i = 0; i < NTL; ++i) { cnt += __builtin_popcountll(__ballot(key[i] >= cand)); if ((i & 3) == 3) __builtin_amdgcn_sched_barrier(0); }
        if (cnt >= 256) { T = cand; if (cnt == 256) { exact = true; break; } }
    }
    unsigned long long myw = 0ull;
    if (exact) {
#pragma unroll
        for (int i = 0; i < NTL; ++i) { const unsigned long long mm = __ballot(key[i] >= T); if (ln == i) myw = mm; if ((i & 3) == 3) __builtin_amdgcn_sched_barrier(0); }
    } else {
        int cgt = 0;
#pragma unroll 1
        for (int i = 0; i < NTL; ++i) { float v = slane[64 * i]; v = (64 * i + ln < nvq) ? v : -__builtin_inff(); const unsigned ub = __float_as_uint(v); const unsigned k = (ub & 0x80000000u) ? ~ub : (ub | 0x80000000u);
            cgt += __builtin_popcountll(__ballot(k > T)); }
        int need = 256 - cgt;
#pragma unroll 1
        for (int i = 0; i < NTL; ++i) { float v = slane[64 * i]; v = (64 * i + ln < nvq) ? v : -__builtin_inff(); const unsigned ub = __float_as_uint(v); const unsigned k = (ub & 0x80000000u) ? ~ub : (ub | 0x80000000u);
            const unsigned long long mgt = __ballot(k > T); unsigned long long meq = __ballot(k == T); int ce = __builtin_popcountll(meq);
            while (ce > need) { meq &= ~(1ull << (63 - __builtin_clzll(meq))); --ce; }
            need -= ce; const unsigned long long mm = mgt | meq; if (ln == i) myw = mm; }
    }
    return myw;
}
__device__ __forceinline__ void idx_item(Frame& F, int it) {
    bool samp = false; int b, c, qh = 0;
    if (it < 128) { c = 31 - (it >> 4); b = (it >> 1) & 7; qh = it & 1; }
    else if (it < 160) { samp = true; c = 32; b = it - 128; }
    else if (it < 480) { const int k = it - 160; c = 23 - (k >> 4); b = (k >> 1) & 7; qh = k & 1; }
    else { const int k = it - 480; c = k >> 3; b = k & 7; }
    unsigned long long* MASK = WSP(unsigned long long, WS_MASK);
    if (it >= 480) {
        const int ntp4 = (c + 2) & ~1, R0 = 2048 * b + 64 * c;
        for (int i = F.tid; i < 64 * ntp4; i += NTHREADS) { const int q = i / ntp4, t = i - q * ntp4; MASK[(size_t)(R0 + q) * MTILES + t] = (t <= c) ? ~0ull : 0ull; }
        return;
    }
    const int Rq0 = samp ? MP + 32 * b : 2048 * b + 64 * c + 32 * qh;
    const int ntile = samp ? 33 : c + 1;
    const int ntp = samp ? 34 : ((c + 2) & ~1);
    float* SC = WSP(float, WS_H) + (size_t)blockIdx.x * 32 * SCW;
    const bf16* KI = samp ? WSP(bf16, WS_KICAT) + (size_t)b * LCAT * IDXD : WSP(bf16, WS_KIP) + (size_t)b * 2048 * IDXD;
    const bf16* QIb = WSP(bf16, WS_QI); const float* WIb = WSP(float, WS_WI);
    int l_ = F.lane; asm volatile("" : "+v"(l_));
    const int r32 = l_ & 31, hi = l_ >> 5;
    const int nkb = samp ? 65 : 2 * (c + 1);
    constexpr int QL_PITCH = 2064;
    static_assert(32 * QL_PITCH + 2048 <= LDSCTL_OFF, "q_idx image + w_idx rows fit under the LDS control words");
    LAS unsigned char* QL = F.lds;
    { int t_ = F.tid; asm volatile("" : "+v"(t_));
      for (int i = t_; i < 32 * 128; i += NTHREADS) { const int q = i >> 7, ch = i & 127; *(LAS v4u*)(QL + q * QL_PITCH + ch * 16) = *(const v4u*)(QIb + (size_t)(Rq0 + q) * IDXW + ch * 8); }
      if (t_ < 128) *(LAS v4u*)(QL + 32 * QL_PITCH + t_ * 16) = *(const v4u*)(WIb + (size_t)Rq0 * 16 + t_ * 4); }
    __syncthreads();
    const LAS unsigned char* qp = QL + r32 * QL_PITCH + 16 * hi;
    const LAS float* wl = (const LAS float*)(QL + 32 * QL_PITCH) + r32 * 16;
    bf16x8 kn[4];
    { const bf16* kp = KI + (size_t)(32 * F.wave + r32) * IDXD + 8 * hi;
#pragma unroll
      for (int s = 0; s < 4; ++s) kn[s] = *(const bf16x8*)(kp + 16 * s); }
    for (int kb = F.wave; kb < nkb; kb += NWAVES) {
        bf16x8 kf[4];
#pragma unroll
        for (int s = 0; s < 4; ++s) kf[s] = kn[s];
        if (kb + NWAVES < nkb) { const bf16* kp = KI + (size_t)(32 * (kb + NWAVES) + r32) * IDXD + 8 * hi;
#pragma unroll
            for (int s = 0; s < 4; ++s) kn[s] = *(const bf16x8*)(kp + 16 * s); }
        f32x16 sc;
#pragma unroll
        for (int r = 0; r < 16; ++r) sc[r] = 0.f;
#pragma unroll
        for (int h = 0; h < 16; ++h) {
            bf16x8 qf[4];
#pragma unroll
            for (int s = 0; s < 4; ++s) qf[s] = *(const LAS bf16x8*)(qp + 128 * h + 32 * s);
            f32x16 C;
#pragma unroll
            for (int r = 0; r < 16; ++r) C[r] = 0.f;
#pragma unroll
            for (int s = 0; s < 4; ++s) C = __builtin_amdgcn_mfma_f32_32x32x16_bf16(kf[s], qf[s], C, 0, 0, 0);
            const float wh = wl[h];
#pragma unroll
            for (int r = 0; r < 16; ++r) sc[r] = __builtin_fmaf(wh, __builtin_amdgcn_fmed3f(C[r], 0.f, __builtin_inff()), sc[r]);
            asm volatile("" : "+v"(sc));
            if (h & 1) __builtin_amdgcn_sched_barrier(0);
        }
        float* sp = SC + (size_t)r32 * SCW + 32 * kb + 4 * hi;
#pragma unroll
        for (int gq = 0; gq < 4; ++gq) *(f32x4*)(sp + 8 * gq) = (f32x4){sc[4 * gq], sc[4 * gq + 1], sc[4 * gq + 2], sc[4 * gq + 3]};
    }
    VM_WAIT(); __syncthreads();
    const int nvalid = samp ? 2080 : 64 * (c + 1);
    for (int qq = F.wave; qq < 32; qq += NWAVES) {
        const float* srow = SC + (size_t)qq * SCW;
        unsigned long long myw;
        if (ntile <= 9) myw = select_query<9>(srow, F.lane, nvalid);
        else if (ntile <= 17) myw = select_query<17>(srow, F.lane, nvalid);
        else if (ntile <= 25) myw = select_query<25>(srow, F.lane, nvalid);
        else myw = select_query<33>(srow, F.lane, nvalid);
        if (F.lane < ntp) MASK[(size_t)(Rq0 + qq) * MTILES + F.lane] = myw;
    }
}

namespace att {
constexpr int D = 128, KVBLK = 64;
constexpr float SCALE = 0.088388347648318440f;
constexpr float THR = 8.f;
constexpr int LDK = KVW;
constexpr size_t SHM_V = KVBLK * D * 2, SHM_K = KVBLK * D * 2;
constexpr int OFF_WS = 2 * SHM_V + 2 * SHM_K, OFF_MK = OFF_WS + NWAVES * 64 * 4;
#define KSWZ(row, colB) ((row) * 256 + ((colB) ^ (((row) & 7) << 4)))
#define SBAR() __builtin_amdgcn_sched_barrier(0)
__device__ __forceinline__ int crow(int r, int hi) { return (r & 3) + 8 * (r >> 2) + 4 * hi; }
__device__ __forceinline__ unsigned cvtpk(float lo, float hi) { unsigned r; asm volatile("v_cvt_pk_bf16_f32 %0, %1, %2" : "=v"(r) : "v"(lo), "v"(hi)); return r; }
__device__ __forceinline__ void partialSM(f32x16& p0, f32x16& p1, float& m_reg, float& mn, float& alpha) {
  constexpr float C = SCALE * 1.4426950408889634f;
  float pmax = p0[0];
#pragma unroll
  for (int r = 1; r < 16; ++r) pmax = fmaxf(pmax, p0[r]);
#pragma unroll
  for (int r = 0; r < 16; ++r) pmax = fmaxf(pmax, p1[r]);
  { auto rr = __builtin_amdgcn_permlane32_swap(__float_as_uint(pmax), __float_as_uint(pmax), false, false);
    pmax = fmaxf(__uint_as_float(rr[0]), __uint_as_float(rr[1])); }
  if (__builtin_expect(__all(pmax - m_reg <= THR / SCALE), 1)) { mn = m_reg; alpha = 1.f; }
  else { mn = fmaxf(m_reg, pmax); alpha = __builtin_amdgcn_exp2f((m_reg - mn) * C); m_reg = mn; }
  float mnC = -mn * C;
#pragma unroll
  for (int r = 0; r < 16; ++r) p0[r] = fmaf(p0[r], C, mnC);
#pragma unroll
  for (int r = 0; r < 16; ++r) p1[r] = fmaf(p1[r], C, mnC);
#pragma unroll
  for (int r = 0; r < 16; ++r) p0[r] = __builtin_amdgcn_exp2f(p0[r]);
}
__device__ __forceinline__ void finishSM(f32x16& p0, f32x16& p1, float alpha, float& l_reg, bf16x8& pa0, bf16x8& pa1, bf16x8& pa2, bf16x8& pa3) {
#pragma unroll
  for (int r = 0; r < 16; ++r) p1[r] = __builtin_amdgcn_exp2f(p1[r]);
  float ps = 0;
#pragma unroll
  for (int r = 0; r < 16; ++r) ps += p0[r];
#pragma unroll
  for (int r = 0; r < 16; ++r) ps += p1[r];
  { auto rr = __builtin_amdgcn_permlane32_swap(__float_as_uint(ps), __float_as_uint(ps), false, false);
    ps = __uint_as_float(rr[0]) + __uint_as_float(rr[1]); }
  l_reg = l_reg * alpha + ps;
#define PK4(P, BASE, OUT) do { unsigned a0 = cvtpk(P[BASE + 0], P[BASE + 1]), a1 = cvtpk(P[BASE + 2], P[BASE + 3]);   \
    unsigned b0 = cvtpk(P[BASE + 4], P[BASE + 5]), b1 = cvtpk(P[BASE + 6], P[BASE + 7]);                              \
    auto r0 = __builtin_amdgcn_permlane32_swap(a0, b0, false, false); auto r1 = __builtin_amdgcn_permlane32_swap(a1, b1, false, false); \
    v4u w = {r0[0], r1[0], r0[1], r1[1]}; OUT = *reinterpret_cast<bf16x8*>(&w); } while (0)
  PK4(p0, 0, pa0); PK4(p0, 8, pa1); PK4(p1, 0, pa2); PK4(p1, 8, pa3);
#undef PK4
}
__device__ __forceinline__ void qkt(f32x16& p0, f32x16& p1, const LAS unsigned char* Ks, const bf16x8* qr, int r32, int hi, unsigned long long mw) {
#pragma unroll
  for (int r = 0; r < 16; ++r) { p0[r] = 0.f; p1[r] = 0.f; }
#pragma unroll
  for (int d0 = 0; d0 < 8; ++d0) { int cb = (d0 * 16 + hi * 8) * 2;
    bf16x8 b0 = *reinterpret_cast<const LAS bf16x8*>(Ks + KSWZ(r32, cb));
    bf16x8 b1 = *reinterpret_cast<const LAS bf16x8*>(Ks + KSWZ(32 + r32, cb));
    p0 = __builtin_amdgcn_mfma_f32_32x32x16_bf16(b0, qr[d0], p0, 0, 0, 0);
    p1 = __builtin_amdgcn_mfma_f32_32x32x16_bf16(b1, qr[d0], p1, 0, 0, 0); }
  const unsigned lo = (unsigned)mw >> (4 * hi), hw = (unsigned)(mw >> 32) >> (4 * hi);
  const float ninf = -__builtin_inff();
#pragma unroll
  for (int r = 0; r < 16; ++r) { const int bit = (r & 3) + 8 * (r >> 2); p0[r] = ((lo >> bit) & 1u) ? p0[r] : ninf; p1[r] = ((hw >> bit) & 1u) ? p1[r] : ninf; }
}
__device__ __forceinline__ int v_st(int k, int c) { const int kk = (k & ~0xC) | ((k & 4) << 1) | ((k & 8) >> 1); return ((kk >> 3) * 4 + (c >> 5)) * 512 + ((kk & 7) * 32 + (c & 31)) * 2; }
__device__ __forceinline__ int v_rd_base(int lane) { return ((lane & 3) << 3) | (((lane >> 2) & 3) << 6) | (((lane >> 4) & 1) << 5) | (((lane >> 5) & 1) << 8); }
constexpr int v_rd_off(int d0, int ks, int half) { return d0 * 512 + ks * 4096 + half * 2048; }
template <int OFF> __device__ __forceinline__ s16x4 tr_read(int vb) {
  s16x4 r; asm volatile("ds_read_b64_tr_b16 %0, %1 offset:%2" : "=&v"(r) : "v"(vb), "i"(OFF) : "memory"); return r;
}
template <int D0> __device__ __forceinline__ void pv_one(f32x16& od, int vb, bf16x8 pa0, bf16x8 pa1, bf16x8 pa2, bf16x8 pa3) {
  const s16x4 l0 = tr_read<v_rd_off(D0, 0, 0)>(vb), h0 = tr_read<v_rd_off(D0, 0, 1)>(vb), l1 = tr_read<v_rd_off(D0, 1, 0)>(vb), h1 = tr_read<v_rd_off(D0, 1, 1)>(vb);
  const s16x4 l2 = tr_read<v_rd_off(D0, 2, 0)>(vb), h2 = tr_read<v_rd_off(D0, 2, 1)>(vb), l3 = tr_read<v_rd_off(D0, 3, 0)>(vb), h3 = tr_read<v_rd_off(D0, 3, 1)>(vb);
  asm volatile("s_waitcnt lgkmcnt(0)" ::: "memory"); SBAR();
#define PK(L, H) (bf16x8){L[0], L[1], L[2], L[3], H[0], H[1], H[2], H[3]}
  od = __builtin_amdgcn_mfma_f32_32x32x16_bf16(pa0, PK(l0, h0), od, 0, 0, 0);
  od = __builtin_amdgcn_mfma_f32_32x32x16_bf16(pa1, PK(l1, h1), od, 0, 0, 0);
  od = __builtin_amdgcn_mfma_f32_32x32x16_bf16(pa2, PK(l2, h2), od, 0, 0, 0);
  od = __builtin_amdgcn_mfma_f32_32x32x16_bf16(pa3, PK(l3, h3), od, 0, 0, 0);
#undef PK
}
__device__ __forceinline__ void pv_d0(f32x16* o, int vb, bf16x8 pa0, bf16x8 pa1, bf16x8 pa2, bf16x8 pa3) {
  pv_one<0>(o[0], vb, pa0, pa1, pa2, pa3); pv_one<1>(o[1], vb, pa0, pa1, pa2, pa3); pv_one<2>(o[2], vb, pa0, pa1, pa2, pa3); pv_one<3>(o[3], vb, pa0, pa1, pa2, pa3);
}
struct F8 { f32x4 lo, hi; };
template <bool F32SRC>
__device__ __forceinline__ void attn_unit(const bf16* Qw, const bf16* __restrict__ Kh, const bf16* __restrict__ Vh, const float* __restrict__ Kf, const float* __restrict__ Vf, bf16* Ow, const LAS unsigned long long* mrow, int NT, bool active, LAS unsigned char* lds) {
  const int tid = threadIdx.x, wid = tid >> 6, lane = tid & 63, r32 = lane & 31, hi = lane >> 5;
  LAS unsigned char* V_lds = lds; LAS unsigned char* K_lds = lds + 2 * SHM_V;
  LAS float* ws = (LAS float*)(lds + OFF_WS) + wid * 64; LAS float* li_l = ws; LAS float* al_l = ws + 32;
  float m_reg = -1e30f, l_reg = 0; f32x16 o[4]; bf16x8 qr[8];
#pragma unroll
  for (int d = 0; d < 4; ++d)
#pragma unroll
    for (int r = 0; r < 16; ++r) o[d][r] = 0.f;
#pragma unroll
  for (int d0 = 0; d0 < 8; ++d0) qr[d0] = *reinterpret_cast<const bf16x8*>(Qw + d0 * 16);
  const int sr = tid >> 4, sc = (tid & 15) * 8, vst0 = v_st(sr, sc), vst1 = v_st(32 + sr, sc);
  const int vb0 = (int)(uintptr_t)V_lds + v_rd_base(lane);
  bf16x8 vsA0, vsA1, ksA0, ksA1, vsB0, vsB1, ksB0, ksB1;
  F8 vfA0, vfA1, kfA0, kfA1;
#define F8LD(p) (F8){*(const f32x4*)(p), *(const f32x4*)((p) + 4)}
#define F8BF(p) ({ const v4u w_ = *(const v4u*)(p); (F8){(f32x4){bf_lo(w_.x), bf_hi(w_.x), bf_lo(w_.y), bf_hi(w_.y)}, (f32x4){bf_lo(w_.z), bf_hi(w_.z), bf_lo(w_.w), bf_hi(w_.w)}}; })
#define SLOADF(S, k0) do { const long r0_ = (long)((k0) + sr) * LDK + sc, r1_ = (long)((k0) + 32 + sr) * LDK + sc; \
    if ((k0) < 2048) { vf##S##0 = F8LD(Vf + r0_); vf##S##1 = F8LD(Vf + r1_); kf##S##0 = F8LD(Kf + r0_); kf##S##1 = F8LD(Kf + r1_); } \
    else { vf##S##0 = F8BF(Vh + r0_); vf##S##1 = F8BF(Vh + r1_); kf##S##0 = F8BF(Kh + r0_); kf##S##1 = F8BF(Kh + r1_); } } while (0)
#define SWRITEF(b, S) do { *(LAS v4u*)(V_lds + (b) * SHM_V + vst0) = pack8((vf##S##0).lo, (vf##S##0).hi); *(LAS v4u*)(V_lds + (b) * SHM_V + vst1) = pack8((vf##S##1).lo, (vf##S##1).hi); const int kc = sc * 2; \
    *(LAS v4u*)(K_lds + (b) * SHM_K + KSWZ(sr, kc)) = pack8((kf##S##0).lo, (kf##S##0).hi); *(LAS v4u*)(K_lds + (b) * SHM_K + KSWZ(32 + sr, kc)) = pack8((kf##S##1).lo, (kf##S##1).hi); } while (0)
#define SLOAD(S, k0) do { vs##S##0 = *reinterpret_cast<const bf16x8*>(&Vh[(long)((k0) + sr) * LDK + sc]); vs##S##1 = *reinterpret_cast<const bf16x8*>(&Vh[(long)((k0) + 32 + sr) * LDK + sc]); \
    ks##S##0 = *reinterpret_cast<const bf16x8*>(&Kh[(long)((k0) + sr) * LDK + sc]); ks##S##1 = *reinterpret_cast<const bf16x8*>(&Kh[(long)((k0) + 32 + sr) * LDK + sc]); } while (0)
#define SWRITE(b, S) do { *(LAS bf16x8*)(V_lds + (b) * SHM_V + vst0) = vs##S##0; *(LAS bf16x8*)(V_lds + (b) * SHM_V + vst1) = vs##S##1; const int kc = sc * 2; \
    *(LAS bf16x8*)(K_lds + (b) * SHM_K + KSWZ(sr, kc)) = ks##S##0; *(LAS bf16x8*)(K_lds + (b) * SHM_K + KSWZ(32 + sr, kc)) = ks##S##1; } while (0)
#define SWAIT() asm volatile("s_waitcnt vmcnt(4)" ::: "memory")
#define RESC(a) do { if (__any((a) < 1.f)) { if (hi == 0) al_l[r32] = (a); asm volatile("s_waitcnt lgkmcnt(0)" ::: "memory"); \
    _Pragma("unroll") for (int d = 0; d < 4; ++d) _Pragma("unroll") for (int r = 0; r < 16; ++r) o[d][r] *= al_l[crow(r, hi)]; } } while (0)
  f32x16 p0, p1; float mn, al = 1.f; bf16x8 pa0, pa1, pa2, pa3;
#define TILE(buf, tt) do { if (active) { qkt(p0, p1, K_lds + (buf) * SHM_K, qr, r32, hi, mrow[tt]); partialSM(p0, p1, m_reg, mn, al); RESC(al); \
    finishSM(p0, p1, al, l_reg, pa0, pa1, pa2, pa3); SBAR(); pv_d0(o, vb0 + (buf) * (int)SHM_V, pa0, pa1, pa2, pa3); } } while (0)
  if constexpr (F32SRC) {
    SLOADF(A, 0);
    for (int j = 0; j < NT; ++j) { const int buf = j & 1;
      SWRITEF(buf, A); __syncthreads();
      if (j + 1 < NT) SLOADF(A, (j + 1) * KVBLK);
      TILE(buf, j);
    }
  } else {
    SLOAD(A, 0); SLOAD(B, KVBLK);
    for (int j = 0; j < NT; j += 2) {
      SWRITE(0, A); __syncthreads();
      if (j + 2 < NT) SLOAD(A, (j + 2) * KVBLK);
      TILE(0, j);
      SWRITE(1, B); __syncthreads();
      if (j + 3 < NT) SLOAD(B, (j + 3) * KVBLK);
      TILE(1, j + 1);
    }
  }
  if (active) {
    if (hi == 0) li_l[r32] = l_reg; asm volatile("s_waitcnt lgkmcnt(0)" ::: "memory");
    float rli[16];
#pragma unroll
    for (int r = 0; r < 16; ++r) rli[r] = __builtin_amdgcn_rcpf(li_l[crow(r, hi)]);
#pragma unroll
    for (int r = 0; r < 16; ++r) { const int orow = crow(r, hi);
#pragma unroll
      for (int d0 = 0; d0 < 4; ++d0) Ow[(long)orow * QW + d0 * 32 + r32] = f2bf1(o[d0][r] * rli[r]); }
  }
#undef TILE
#undef SLOAD
#undef SWRITE
#undef SLOADF
#undef SWRITEF
#undef F8LD
#undef F8BF
#undef SWAIT
#undef RESC
}
#undef KSWZ
}

__device__ __forceinline__ void attn_item(Frame& F, int it, bool dry = false) {
    bool samp; int b, c, n;
    if (it < 512) { samp = false; c = 31 - (it >> 5); b = (it >> 2) & 7; n = it & 3; }
    else if (it < 640) { samp = true; c = 32; b = (it - 512) >> 2; n = it & 3; }
    else { samp = false; c = 15 - ((it - 640) >> 5); b = ((it - 640) >> 2) & 7; n = it & 3; }
    const int R0 = samp ? MP + 32 * b : 2048 * b + 64 * c;
    const int NT = samp ? 34 : ((c + 2) & ~1);
    const int nq = samp ? 32 : 64;
    { const v4u* src = (const v4u*)(WSP(unsigned long long, WS_MASK) + (size_t)R0 * MTILES); LAS v4u* dst = (LAS v4u*)(F.lds + att::OFF_MK);
      for (int i = F.tid; i < nq * MTILES / 2; i += NTHREADS) dst[i] = src[i]; }
    const int g = F.wave & 3, qhalf = samp ? 0 : (F.wave >> 2), r32 = F.lane & 31, hi = F.lane >> 5;
    const bool active = samp ? (F.wave < 4) : true;
    const int qloc = 32 * qhalf + r32;
    bf16* Qb = WSP(bf16, WS_Q) + (size_t)(R0 + qloc) * QW + (4 * n + g) * 128;
    const bf16* Kh = samp ? WSP(bf16, WS_KCAT) + (size_t)b * LCAT * KVW + 128 * n : WSP(bf16, WS_KP) + (size_t)b * 2048 * KVW + 128 * n;
    const bf16* Vh = samp ? WSP(bf16, WS_VCAT) + (size_t)b * LCAT * KVW + 128 * n : WSP(bf16, WS_VP) + (size_t)b * 2048 * KVW + 128 * n;
    const LAS unsigned long long* mrow = (const LAS unsigned long long*)(F.lds + att::OFF_MK) + qloc * MTILES;
    bf16* Ow = (dry ? WSP(bf16, WS_H) : WSP(bf16, WS_Q)) + (size_t)(R0 + 32 * qhalf) * QW + (4 * n + g) * 128;
    if (samp) { const float* Kf = INP(2) + (size_t)b * 2048 * KVW + 128 * n; const float* Vf = INP(3) + (size_t)b * 2048 * KVW + 128 * n;
        att::attn_unit<true>(Qb + hi * 8, Kh, Vh, Kf, Vf, Ow, mrow, NT, active, F.lds); }
    else att::attn_unit<false>(Qb + hi * 8, Kh, Vh, nullptr, nullptr, Ow, mrow, NT, active, F.lds);
}

__device__ __forceinline__ void p6_sample_rows(Frame& F) {
    const int sw = F.wave * F.G + F.vcu, NGW = F.G * NWAVES;
    float* ssq2 = (float*)(F.ctl + CW_SSQ2);
    for (int r = sw; r < MS; r += NGW) {
        const int m = MP + r, p = m & 255;
        const GAS f32x4* xr = (const GAS f32x4*)(INP(1) + (size_t)r * DM) + 2 * F.lane; const GAS f32x4* pr = (const GAS f32x4*)(WSP(float, WS_PART) + (size_t)r * DM) + 2 * F.lane;
        GAS v4u* dst = (GAS v4u*)(WSP(bf16, WS_X1B) + (size_t)((m & ~255) + perm_row(p)) * DM) + F.lane;
        constexpr size_t PL = (size_t)MS * DM / 4;
        float s = 0.f;
#pragma unroll
        for (int j = 0; j < 8; ++j) { const int o = 128 * j;
            const f32x4 v0 = xr[o] + ((pr[o] + pr[o + PL]) + (pr[o + 2 * PL] + pr[o + 3 * PL])), v1 = xr[o + 1] + ((pr[o + 1] + pr[o + 1 + PL]) + (pr[o + 1 + 2 * PL] + pr[o + 1 + 3 * PL]));
            s += (v0[0] * v0[0] + v0[1] * v0[1]) + (v0[2] * v0[2] + v0[3] * v0[3]) + (v1[0] * v1[0] + v1[1] * v1[1]) + (v1[2] * v1[2] + v1[3] * v1[3]);
            dst[64 * j] = pack8(v0, v1); }
        s = wave_sum(s);
        if (F.lane == 0) ssq2[m] = s;
    }
}
__device__ __forceinline__ void p1_finish(Frame& F) {
    const int gt = F.vcu * NTHREADS + F.tid, NGT = F.G * NTHREADS;
    const float* PT = (const float*)F.out; constexpr size_t PL = (size_t)MT * 128;
    const float* tabI = WSP(float, WS_TABI);
    for (int i = gt; i < MT * 9; i += NGT) {
        const int row = i / 9, task = i - row * 9;
        const bool samp = row >= MP; const int r2 = row - MP;
        const float* p = PT + (size_t)row * 128;
        if (task >= 7) { const int c = 64 + 8 * (task - 7);
            const f32x4 a = (*(const f32x4*)(p + c) + *(const f32x4*)(p + PL + c)) + *(const f32x4*)(p + 2 * PL + c), b = (*(const f32x4*)(p + c + 4) + *(const f32x4*)(p + PL + c + 4)) + *(const f32x4*)(p + 2 * PL + c + 4);
            float* wp = WSP(float, WS_WI) + (size_t)row * 16 + 8 * (task - 7); *(f32x4*)wp = a * 0.03125f; *(f32x4*)(wp + 4) = b * 0.03125f; continue; }
        const size_t drow = samp ? (size_t)((r2 >> 5) * LCAT + 2048 + (r2 & 31)) : (size_t)row;
        bf16* kd = (samp ? WSP(bf16, WS_KICAT) : WSP(bf16, WS_KIP)) + drow * IDXD;
        float* od = F.out + (samp ? O_KIS : O_KIP) + (size_t)(samp ? r2 : row) * IDXD;
        if (task == 0) {
            f32x4 v[4];
#pragma unroll
            for (int q = 0; q < 4; ++q) v[q] = (*(const f32x4*)(p + 4 * q) + *(const f32x4*)(p + PL + 4 * q)) + *(const f32x4*)(p + 2 * PL + 4 * q);
            const int pos = samp ? 2048 + (r2 & 31) : (row & 2047);
            const f32x4* tp = (const f32x4*)(tabI + pos * 16); const f32x4 t0 = tp[0], t1 = tp[1], t2 = tp[2], t3 = tp[3];
            const float cs[8] = {t0[0], t0[2], t1[0], t1[2], t2[0], t2[2], t3[0], t3[2]}, sn[8] = {t0[1], t0[3], t1[1], t1[3], t2[1], t2[3], t3[1], t3[3]};
            f32x4 o[4];
#pragma unroll
            for (int j = 0; j < 8; ++j) { const float x1 = v[j >> 2][j & 3], x2 = v[2 + (j >> 2)][j & 3]; o[j >> 2][j & 3] = x1 * cs[j] - x2 * sn[j]; o[2 + (j >> 2)][j & 3] = x2 * cs[j] + x1 * sn[j]; }
            *(v4u*)kd = pack8(o[0], o[1]); *(v4u*)(kd + 8) = pack8(o[2], o[3]);
#pragma unroll
            for (int q = 0; q < 4; ++q) *(f32x4*)(od + 4 * q) = o[q];
        } else { const int c = 8 * (task + 1);
            const f32x4 a = (*(const f32x4*)(p + c) + *(const f32x4*)(p + PL + c)) + *(const f32x4*)(p + 2 * PL + c), b = (*(const f32x4*)(p + c + 4) + *(const f32x4*)(p + PL + c + 4)) + *(const f32x4*)(p + 2 * PL + c + 4);
            *(v4u*)(kd + c) = pack8(a, b); *(f32x4*)(od + c) = a; *(f32x4*)(od + c + 4) = b; }
    }
}
__device__ __forceinline__ void p8_fixup(Frame& F) {
    const int gt = F.vcu * NTHREADS + F.tid, NGT = F.G * NTHREADS;
    const float* ZF = WSP(float, WS_H); const float* ZL = ZF + (size_t)128 * 2 * NUP;
    const float* cw = INP(16); const float* cb = INP(17); bf16* ACT = WSP(bf16, WS_ACT);
    constexpr int C4 = DFF / 4;
    for (int i = gt; i < 128 * C4; i += NGT) {
        const int beta = i / C4, cg = 4 * (i - beta * C4), cu = DFF + cg;
        if ((beta & 15) == 0) continue;
        const float* zl = ZL + (size_t)(beta - 1) * 2 * NUP; const float* zf = ZF + (size_t)beta * 2 * NUP;
        const f32x4 g2 = *(const f32x4*)(zl + cg), g1 = *(const f32x4*)(zl + NUP + cg), ga = *(const f32x4*)(zf + cg), gb = *(const f32x4*)(zf + NUP + cg);
        const f32x4 u2 = *(const f32x4*)(zl + cu), u1 = *(const f32x4*)(zl + NUP + cu), ua = *(const f32x4*)(zf + cu), ub = *(const f32x4*)(zf + NUP + cu);
        const f32x4 w0g = *(const f32x4*)(cw + cg), w1g = *(const f32x4*)(cw + NUP + cg), w2g = *(const f32x4*)(cw + 2 * NUP + cg), bg = *(const f32x4*)(cb + cg);
        const f32x4 w0u = *(const f32x4*)(cw + cu), w1u = *(const f32x4*)(cw + NUP + cu), w2u = *(const f32x4*)(cw + 2 * NUP + cu), bu = *(const f32x4*)(cb + cu);
        const f32x4 cg0 = bg + w0g * g2 + w1g * g1 + w2g * ga, cu0 = bu + w0u * u2 + w1u * u1 + w2u * ua;
        const f32x4 cg1 = bg + w0g * g1 + w1g * ga + w2g * gb, cu1 = bu + w0u * u1 + w1u * ua + w2u * ub;
        f32x4 a0, a1;
#pragma unroll
        for (int k = 0; k < 4; ++k) { a0[k] = cg0[k] * sigmoidf_(cg0[k]) * cu0[k]; a1[k] = cg1[k] * sigmoidf_(cg1[k]) * cu1[k]; }
        v2u w0, w1; w0.x = cvt_pk_bf16(a0[0], a0[1]); w0.y = cvt_pk_bf16(a0[2], a0[3]); w1.x = cvt_pk_bf16(a1[0], a1[1]); w1.y = cvt_pk_bf16(a1[2], a1[3]);
        bf16* ap = ACT + (size_t)(128 * beta) * DFF + cg;
        *(v2u*)ap = w0; *(v2u*)(ap + DFF) = w1;
    }
}
__device__ __forceinline__ void p10_final(Frame& F) {
    const int gw = F.vcu * NWAVES + F.wave, NGW = F.G * NWAVES;
    const GAS f32x4* gr = (const GAS f32x4*)INP(19) + F.lane;
    constexpr size_t PL = (size_t)MS * DM / 4;
    const int sw = F.wave * F.G + F.vcu, np = gw < MP ? (MP - gw + NGW - 1) / NGW : 0, ns = sw < MS ? (MS - sw + NGW - 1) / NGW : 0;
    for (int i = 0; i < np + ns; ++i) { const int m = i < np ? gw + i * NGW : MP + sw + (i - np) * NGW;
        f32x4 v[16];
        if (m < MP) { const GAS v2u* xr = (const GAS v2u*)(WSP(bf16, WS_X2B) + (size_t)m * DM) + F.lane;
#pragma unroll
            for (int j = 0; j < 16; ++j) { const v2u w = xr[64 * j]; v[j] = (f32x4){bf_lo(w.x), bf_hi(w.x), bf_lo(w.y), bf_hi(w.y)}; } }
        else { const int p = m & 255; const GAS v2u* xr = (const GAS v2u*)(WSP(bf16, WS_X1B) + (size_t)((m & ~255) + perm_row(p)) * DM) + F.lane;
            const GAS f32x4* pr = (const GAS f32x4*)(WSP(float, WS_PART) + (size_t)(m - MP) * DM) + F.lane;
#pragma unroll
            for (int j = 0; j < 16; ++j) { const v2u w = xr[64 * j]; const int o = 64 * j;
                v[j] = (f32x4){bf_lo(w.x), bf_hi(w.x), bf_lo(w.y), bf_hi(w.y)} + ((pr[o] + pr[o + PL]) + (pr[o + 2 * PL] + pr[o + 3 * PL])); } }
        float s = 0.f;
#pragma unroll
        for (int j = 0; j < 16; ++j) s += (v[j].x * v[j].x + v[j].y * v[j].y) + (v[j].z * v[j].z + v[j].w * v[j].w);
        const float r = 1.f / sqrtf(wave_sum(s) * (1.f / DM) + EPS);
        GAS f32x4* orow = (GAS f32x4*)(F.out + (size_t)m * DM) + F.lane;
#pragma unroll
        for (int j = 0; j < 16; ++j) orow[64 * j] = v[j] * r * gr[64 * j];
    }
}

#ifndef PHMASK
#define PHMASK 0xFFF
#endif
#define PH(k) ((PHMASK >> (k)) & 1)
__global__ void __launch_bounds__(NTHREADS, 2) fwd_kernel(Args args) {
    extern __shared__ __attribute__((aligned(16))) unsigned char lds[];
    Frame F;
    F.lds = (LAS unsigned char*)lds;
    F.MISC = (volatile LAS unsigned*)(F.lds + MISC_OFF);
    F.tid = threadIdx.x; F.lane = F.tid & 63; F.wave = __builtin_amdgcn_readfirstlane(F.tid >> 6);
    F.G = gridDim.x; { const int bx = blockIdx.x; F.vcu = (F.G % 8 == 0) ? (bx % 8) * (F.G / 8) + bx / 8 : bx; }
    F.ka = (KA*)__builtin_amdgcn_kernarg_segment_ptr();
    F.out = args.out; F.ws = args.ws;
    F.ctl = (gu32*)(F.ws + WS_CTL);
    for (int u = F.tid; u < (LDS_BYTES - LDSCTL_OFF) / 4; u += NTHREADS) ((LAS unsigned*)(F.lds + LDSCTL_OFF))[u] = 0u;
    __syncthreads();
    XcdBarrier bar = xcd_barrier_post((unsigned*)(F.ctl + CW_BAR), F.MISC + 8);
#define GRID_BAR() xcd_barrier(bar)
    LAS unsigned char* ring = F.lds;

#if PH(0)
    p0_prologue(F);
#if defined(PROBE_P0)
    p0_prologue(F);
#endif
    GRID_BAR();
#endif
#if PH(1)
    { pg8::Gemm g{WSP(bf16, WS_H), WSP(bf16, WS_W1T), MT, N1, DM, DM}; ProjOrder S; S.init(MT, N1 - 256, F.G, (int)blockIdx.x);
      EpiProj E{F.ws, F.out};
      pg8::gemm_phase<EpiProj, ProjOrder, true, true>(ring, g, S, E);
      for (;;) { const int c = q_next(F, CW_DQ3); if (c >= 204 + 64 + 64 + 128) break;
        if (c < 204) { const int sl = c / 68, koff = sl * 1408;
          pg8::Gemm g2{WSP(bf16, WS_H) + koff, WSP(bf16, WS_W1T) + koff, MT, N1, sl < 2 ? 1408 : 1280, DM}; ThinOrder T{c};
          EpiThinPart EP{F.out + (size_t)sl * MT * 128};
          pg8::gemm_phase<EpiThinPart, ThinOrder, true, true>(ring, g2, T, EP); }
        else if (c < 268) transpose_range(F, INP(11), DA, DM, WSP(bf16, WS_WAT), RowId(), nullptr, 64 * (c - 204) + F.wave, NWAVES, 64 * (c - 204) + 64);
        else if (c < 332) transpose_range(F, INP(12), QW, DM, WSP(bf16, WS_WBT), RowId(), nullptr, 64 * (c - 268) + F.wave, NWAVES, 64 * (c - 268) + 64);
        else transpose_range(F, INP(13), DM, DM, WSP(bf16, WS_WOT), RowId(), nullptr, 64 * (c - 332) + F.wave, NWAVES, 64 * (c - 332) + 64); } }
    GRID_BAR();
    p1_finish(F);
    GRID_BAR();
#endif
#if PH(2)
    for (;;) { const int it = q_next(F, CW_Q2); if (it >= 512) break;
#if defined(PROBE_MIX) || defined(PROBE_IDX)
        idx_item(F, it); __syncthreads();
#endif
        idx_item(F, it); }
    for (;;) { const int i4 = q_next(F, CW_Q2B); if (i4 >= 768) break;
        const int first = i4 < 512 ? 2 * i4 : 512 + i4, cnt = i4 < 512 ? 2 : 1;
#pragma unroll 1
        for (int k = 0; k < cnt; ++k) { gmlp_item(F, first + k); __syncthreads(); } }
    GRID_BAR();
#endif
#if PH(3)
    for (;;) { const int it = q_next(F, CW_Q3); if (it >= 1152) break;
#if defined(PROBE_MIX) || defined(PROBE_ATT)
        attn_item(F, it, true); __syncthreads();
#endif
        attn_item(F, it); }
    GRID_BAR();
#endif
#if PH(4)
    { pg8::Gemm g{WSP(bf16, WS_U), WSP(bf16, WS_WAT), MT, DM, DA, DA}; pg8::StaticOrder S; S.init(MT, DM, F.G, (int)blockIdx.x);
      EpiMergeA E{F.ws, (bf16*)F.out};
      pg8::gemm_phase<EpiMergeA, pg8::StaticOrder, true, true>(ring, g, S, E); }
#endif
#if PH(5)
    { pg8::Gemm g{WSP(bf16, WS_Q), WSP(bf16, WS_WBT), MT, DM, QW, QW}; pg8::StaticOrder S; S.init(MT, DM, F.G, (int)blockIdx.x);
      EpiMergeB E{F.ws, (const bf16*)F.out};
      pg8::gemm_phase<EpiMergeB, pg8::StaticOrder, true, true>(ring, g, S, E); }
    for (;;) { const int b = q_next(F, CW_DQ4); if (b >= 64 * 688 / 64) break;
        transpose_range(F, INP(15), DM, NUP, WSP(bf16, WS_WUPT), RowWup(), INP(14), 64 * b + F.wave, NWAVES, 64 * b + 64); }
    GRID_BAR();
#endif
#if PH(6)
    { pg8::Gemm g{WSP(bf16, WS_H), WSP(bf16, WS_WOT), MP, DM, DM, DM}; pg8::StaticOrder S; S.init(MP, DM, F.G, (int)blockIdx.x);
      EpiX1 E{F.ws, F.ka};
      pg8::gemm_phase<EpiX1, pg8::StaticOrder, true, true>(ring, g, S, E);
      if (F.G == 256) { const int sl = (int)blockIdx.x >> 6;
        pg8::Gemm g2{WSP(bf16, WS_H) + sl * 1024, WSP(bf16, WS_WOT) + sl * 1024, MT, DM, 1024, DM}; RemOrder R{(int)blockIdx.x};
        EpiPart EP{WSP(float, WS_PART) + (size_t)sl * MS * DM};
        pg8::gemm_phase<EpiPart, RemOrder, true, true>(ring, g2, R, EP); }
      for (;;) { const int b = q_next(F, CW_DQ5); if (b >= 100) break; transpose_range(F, INP(18), DFF, DM, WSP(bf16, WS_WDNT), RowId(), nullptr, 64 * b + F.wave, NWAVES, 64 * b + 64); } }
    GRID_BAR();
#endif
#if PH(7)
    p6_sample_rows(F);
    GRID_BAR();
#endif
#if PH(8)
    { pg8::Gemm g{WSP(bf16, WS_U), WSP(bf16, WS_WUPT), MT, NUP, DM, DM}; UpOrder S; S.init(MT, NUP, F.G, (int)blockIdx.x); S.ws = F.ws; S.ka = F.ka; S.par = F.lds + RING_BYTES; S.k = 0; S.initd(F.ctl, F.MISC + 32);
      EpiUp E{F.ws, F.out, F.ka, F.lds + RING_BYTES, 0};
      pg8::gemm_phase<EpiUp, UpOrder, true, true>(ring, g, S, E);
      if (S.dyn) {
        for (;;) { const int b = q_next(F, CW_DQ2); if (b >= 244) break; transpose_range(F, INP(18), DFF, DM, WSP(bf16, WS_WDNT), RowId(), nullptr, 6400 + 64 * b + F.wave, NWAVES, 6400 + 64 * b + 64); } }
      else { const int extra = (68 * 86) % F.G, c = (int)blockIdx.x;
        if (extra == 0) transpose_matrix(F, INP(18), DFF, DM, WSP(bf16, WS_WDNT), RowId(), nullptr, -1, 0, 50, 172);
        else if (c >= extra) transpose_matrix(F, INP(18), DFF, DM, WSP(bf16, WS_WDNT), RowId(), nullptr, c - extra, F.G - extra, 50, 172); }
#if defined(PROBE_P7)
      pg8::gemm_phase<EpiUp, UpOrder, true, true>(ring, g, S, E);
#endif
#if defined(PROBE_P7N)
      { EpiNull EN; pg8::gemm_phase<EpiNull, UpOrder, true, true>(ring, g, S, EN); }
#endif
    }
    GRID_BAR();
#endif
#if PH(9)
    p8_fixup(F);
    GRID_BAR();
#endif
#if PH(10)
    { pg8::Gemm g{WSP(bf16, WS_ACT), WSP(bf16, WS_WDNT), MP, DM, DFF, DFF}; pg8::StaticOrder S; S.init(MP, DM, F.G, (int)blockIdx.x);
      EpiX2 E{F.ws};
#if defined(PROBE_P9N)
      { EpiNull EN; pg8::gemm_phase<EpiNull, pg8::StaticOrder, true, true>(ring, g, S, EN); }
#endif
      pg8::gemm_phase<EpiX2, pg8::StaticOrder, true, true>(ring, g, S, E);
      if (F.G == 256) {
        const int c = (int)blockIdx.x, sl = c >> 6, t = ((c & 63) + 2 * sl) & 63;
        int slow; { const unsigned v = F.lane < 8 ? __hip_atomic_load(F.ctl + CW_CL + 256 * F.lane + 22, RLX_AGENT) : 0u;
          unsigned key = (v >> 16) == 22u ? ((v & 0xffffu) << 3) | (unsigned)F.lane : 0u;
          key = max(key, (unsigned)__shfl_xor((int)key, 1)); key = max(key, (unsigned)__shfl_xor((int)key, 2)); key = max(key, (unsigned)__shfl_xor((int)key, 4));
          slow = (key >> 3) > 183u ? (int)(key & 7u) : -1; }
        slow = __builtin_amdgcn_readfirstlane(slow);
        const int sls = (slow >= 0 && ((t ^ slow) & 1) == 0) ? (((t - slow) >> 1) & 3) : -1;
        const int kt0 = sls < 0 ? (sl < 2 ? 44 * sl : 88 + 42 * (sl - 2)) : 48 * sl - (sl > sls ? 20 : 0), ktn = sls < 0 ? (sl < 2 ? 44 : 42) : (sl == sls ? 28 : 48);
        const int koff = 64 * kt0, klen = 64 * ktn;
        pg8::Gemm g2{WSP(bf16, WS_ACT) + koff, WSP(bf16, WS_WDNT) + koff, MT, DM, klen, DFF}; RemOrder R{t};
        EpiPart EP{WSP(float, WS_PART) + (size_t)sl * MS * DM};
        pg8::gemm_phase<EpiPart, RemOrder, true, true>(ring, g2, R, EP); } }
    GRID_BAR();
#endif
#if PH(11)
    p10_final(F);
#endif
}

extern "C" void kernel_launch(void* const* d_in, const int* in_sizes, int n_in, void* d_out, int out_size, void* d_ws, size_t ws_size, hipStream_t stream) {
    static int grid = 0;
    if (grid == 0) {
        if (n_in != 20 || out_size != (int)O_END || ws_size < WS_END) { fprintf(stderr, "kernel_launch: unexpected shapes: n_in %d out %d ws %zu (need %zu)\n", n_in, out_size, ws_size, (size_t)WS_END); grid = -1; return; }
        int dev = 0, cus = 0, per_cu = 0;
        if (hipGetDevice(&dev) != hipSuccess || hipDeviceGetAttribute(&cus, hipDeviceAttributeMultiprocessorCount, dev) != hipSuccess) { grid = -1; return; }
        if (hipFuncSetAttribute((const void*)fwd_kernel, hipFuncAttributeMaxDynamicSharedMemorySize, LDS_BYTES) != hipSuccess) { fprintf(stderr, "kernel_launch: hipFuncSetAttribute failed\n"); grid = -1; return; }
        if (hipOccupancyMaxActiveBlocksPerMultiprocessor(&per_cu, (const void*)fwd_kernel, NTHREADS, LDS_BYTES) != hipSuccess || per_cu < 1)
            fprintf(stderr, "kernel_launch: note: occupancy query reports %d workgroups per CU\n", per_cu);
        (void)hipGetLastError();
        grid = cus;
    }
    if (grid < 0) return;
    if (hipMemsetAsync((char*)d_ws + WS_CTL, 0, CTL_ZERO_BYTES, stream) != hipSuccess) return;
    Args a{};
    for (int i = 0; i < 20; ++i) a.in[i] = (const float*)d_in[i];
    a.out = (float*)d_out; a.ws = (unsigned char*)d_ws;
    hipLaunchKernelGGL(fwd_kernel, dim3(grid), dim3(NTHREADS), LDS_BYTES, stream, a);
    const hipError_t le = hipPeekAtLastError();
    if (le != hipSuccess) fprintf(stderr, "kernel_launch: launch failed: %s\n", hipGetErrorName(le));
}
```
